# Optimizing an MI355X kernel written in HIP

```python
import math
import jax, jax.numpy as jnp
from jax import lax
import numpy as np

D_MODEL = 1024
BATCH = 16
SEQ = 2048
DEPTH = 1

ATT_HEADS = 8
ATT_HEAD_DIM = D_MODEL // ATT_HEADS // 2
ATT_V_DIM = 2 * ATT_HEAD_DIM
ATT_WIDTH = ATT_HEADS * ATT_V_DIM
Q_BLOCK = 128
SSM_WIDTH = D_MODEL // 2
SSM_GROUP = 16
SSM_GROUPS = SSM_WIDTH // SSM_GROUP
SSM_STATE = 64
DT_MIN = 1e-3
DT_MAX = 1e-1
N_BRANCHES = 2
SPLIT_SIZES = [ATT_WIDTH] * 4 + [SSM_WIDTH] * 2 + [D_MODEL] * N_BRANCHES
IN_WIDTH = sum(SPLIT_SIZES)
EPS = 1e-5

kernel_name = 'hybrid_diffattn_s5_gated_block'


def rmsnorm(x, g):
    xf = x.astype(jnp.float32)
    y = xf * lax.rsqrt(jnp.mean(xf * xf, axis=-1, keepdims=True) + EPS)
    return (y * g.astype(jnp.float32)).astype(x.dtype)


def alibi_slopes(n_heads):
    return jnp.asarray([2.0 ** (-8.0 * (h + 1) / n_heads) for h in range(n_heads)], dtype=jnp.float32)


def diff_attention(q, k, v, lam, lambda_init, subln_g):
    b, L = q.shape[0], q.shape[1]
    q = jnp.transpose(q, (0, 2, 3, 1, 4)).astype(jnp.float32)
    k = jnp.transpose(k, (0, 2, 3, 1, 4)).astype(jnp.float32)
    v = jnp.transpose(v, (0, 2, 1, 3)).astype(jnp.float32)
    scale = ATT_HEAD_DIM ** -0.5
    slopes = alibi_slopes(ATT_HEADS)[None, :, None, None, None]
    outs = []
    for i in range(L // Q_BLOCK):
        q0, k_end = i * Q_BLOCK, (i + 1) * Q_BLOCK
        qs = q[:, :, :, q0:k_end]
        ks = k[:, :, :, :k_end]
        vs = v[:, :, :k_end]
        s = jnp.einsum('bhcqd,bhckd->bhcqk', qs, ks) * scale
        dist = (jnp.arange(q0, k_end)[:, None] - jnp.arange(k_end)[None, :]).astype(jnp.float32)
        s = jnp.where(dist >= 0, s - slopes * dist, -jnp.inf)
        p = jax.nn.softmax(s, axis=-1)
        pd = p[:, :, 0] - lam * p[:, :, 1]
        outs.append(jnp.einsum('bhqk,bhkv->bhqv', pd, vs))
    o = jnp.concatenate(outs, axis=2)
    o = rmsnorm(o, subln_g) * (1.0 - lambda_init)
    return jnp.transpose(o, (0, 2, 1, 3)).reshape(b, L, ATT_WIDTH)


def s5_branch(u, lam_re, lam_im, log_dt, b_re, b_im, c_re, c_im, d_skip, w_glu, b_glu):
    bsz, L = u.shape[0], u.shape[1]
    uf = u.astype(jnp.float32).reshape(bsz, L, SSM_GROUPS, SSM_GROUP)
    dt = jnp.exp(log_dt.astype(jnp.float32))[:, None]
    lre = jnp.minimum(lam_re.astype(jnp.float32), -1e-4)
    lim = lam_im.astype(jnp.float32)
    mag = jnp.exp(lre * dt)
    lbar_re = mag * jnp.cos(lim * dt)
    lbar_im = mag * jnp.sin(lim * dt)
    num_re = lbar_re - 1.0
    den = lre * lre + lim * lim
    coef_re = ((num_re * lre + lbar_im * lim) / den)[..., None]
    coef_im = ((lbar_im * lre - num_re * lim) / den)[..., None]
    bre = b_re.astype(jnp.float32)
    bim = b_im.astype(jnp.float32)
    bbar_re = coef_re * bre - coef_im * bim
    bbar_im = coef_re * bim + coef_im * bre
    bu_re = jnp.einsum('blgh,gph->blgp', uf, bbar_re)
    bu_im = jnp.einsum('blgh,gph->blgp', uf, bbar_im)
    a_re = jnp.broadcast_to(lbar_re, bu_re.shape)
    a_im = jnp.broadcast_to(lbar_im, bu_im.shape)

    def combine(e1, e2):
        a1r, a1i, b1r, b1i = e1
        a2r, a2i, b2r, b2i = e2
        return (a2r * a1r - a2i * a1i,
                a2r * a1i + a2i * a1r,
                a2r * b1r - a2i * b1i + b2r,
                a2r * b1i + a2i * b1r + b2i)

    _, _, st_re, st_im = lax.associative_scan(combine, (a_re, a_im, bu_re, bu_im), axis=1)
    y = (jnp.einsum('blgp,ghp->blgh', st_re, c_re.astype(jnp.float32))
         - jnp.einsum('blgp,ghp->blgh', st_im, c_im.astype(jnp.float32))
         + d_skip.astype(jnp.float32) * uf)
    y = jax.nn.gelu(y).reshape(bsz, L, SSM_WIDTH)
    y = y * jax.nn.sigmoid(y @ w_glu.astype(jnp.float32) + b_glu.astype(jnp.float32))
    return y.astype(u.dtype)


def setup_inputs(seed: int = 0) -> dict:
    key = jax.random.key(seed)
    ks = jax.random.split(key, 24)
    f32 = jnp.float32
    nrm = lambda k, shape, s: jax.random.normal(k, shape, f32) * s
    n_idx = jnp.arange(SSM_STATE, dtype=f32)
    return {
        'x': jax.random.normal(ks[0], (BATCH, SEQ, D_MODEL), f32),
        'norm_g': 1.0 + nrm(ks[1], (DEPTH, D_MODEL), 0.02),
        'w_in': nrm(ks[2], (DEPTH, D_MODEL, IN_WIDTH), D_MODEL ** -0.5),
        'lambda_q1': nrm(ks[3], (DEPTH, ATT_HEAD_DIM), 0.1),
        'lambda_k1': nrm(ks[4], (DEPTH, ATT_HEAD_DIM), 0.1),
        'lambda_q2': nrm(ks[5], (DEPTH, ATT_HEAD_DIM), 0.1),
        'lambda_k2': nrm(ks[6], (DEPTH, ATT_HEAD_DIM), 0.1),
        'subln_g': 1.0 + nrm(ks[7], (DEPTH, ATT_V_DIM), 0.02),
        'w_o_att': nrm(ks[8], (DEPTH, ATT_WIDTH, D_MODEL), ATT_WIDTH ** -0.5),
        'ssm_lambda_re': -0.5 + nrm(ks[9], (DEPTH, SSM_GROUPS, SSM_STATE), 0.01),
        'ssm_lambda_im': math.pi * n_idx + nrm(ks[10], (DEPTH, SSM_GROUPS, SSM_STATE), 0.01),
        'ssm_log_dt': jax.random.uniform(ks[11], (DEPTH, SSM_GROUPS), f32, math.log(DT_MIN), math.log(DT_MAX)),
        'ssm_b_re': nrm(ks[12], (DEPTH, SSM_GROUPS, SSM_STATE, SSM_GROUP), (2 * SSM_GROUP) ** -0.5),
        'ssm_b_im': nrm(ks[13], (DEPTH, SSM_GROUPS, SSM_STATE, SSM_GROUP), (2 * SSM_GROUP) ** -0.5),
        'ssm_c_re': nrm(ks[14], (DEPTH, SSM_GROUPS, SSM_GROUP, SSM_STATE), SSM_STATE ** -0.5),
        'ssm_c_im': nrm(ks[15], (DEPTH, SSM_GROUPS, SSM_GROUP, SSM_STATE), SSM_STATE ** -0.5),
        'ssm_d': nrm(ks[16], (DEPTH, SSM_GROUPS, SSM_GROUP), 1.0),
        'w_glu': nrm(ks[17], (DEPTH, SSM_WIDTH, SSM_WIDTH), SSM_WIDTH ** -0.5),
        'b_glu': nrm(ks[18], (DEPTH, SSM_WIDTH), 0.01),
        'w_o_ssm': nrm(ks[19], (DEPTH, SSM_WIDTH, D_MODEL), SSM_WIDTH ** -0.5),
        'w_out': nrm(ks[20], (DEPTH, D_MODEL, D_MODEL), D_MODEL ** -0.5),
        'final_g': 1.0 + nrm(ks[21], (D_MODEL,), 0.02),
    }


def reference(x, norm_g, w_in, lambda_q1, lambda_k1, lambda_q2, lambda_k2, subln_g, w_o_att,
              ssm_lambda_re, ssm_lambda_im, ssm_log_dt, ssm_b_re, ssm_b_im, ssm_c_re, ssm_c_im,
              ssm_d, w_glu, b_glu, w_o_ssm, w_out, final_g):
    bsz, L = x.shape[0], x.shape[1]
    split_points = [int(v) for v in np.cumsum(SPLIT_SIZES)[:-1]]
    for l in range(DEPTH):
        lambda_init = 0.8 - 0.6 * math.exp(-0.3 * l)
        h = rmsnorm(x, norm_g[l])
        proj = h @ w_in[l]
        q, k, v, z_att, u, z_ssm, g_att, g_ssm = jnp.split(proj, split_points, axis=-1)
        q = q.reshape(bsz, L, ATT_HEADS, 2, ATT_HEAD_DIM)
        k = k.reshape(bsz, L, ATT_HEADS, 2, ATT_HEAD_DIM)
        v = v.reshape(bsz, L, ATT_HEADS, ATT_V_DIM)
        lam = (jnp.exp(jnp.sum(lambda_q1[l].astype(jnp.float32) * lambda_k1[l].astype(jnp.float32)))
               - jnp.exp(jnp.sum(lambda_q2[l].astype(jnp.float32) * lambda_k2[l].astype(jnp.float32)))
               + lambda_init)
        att = diff_attention(q, k, v, lam, lambda_init, subln_g[l]).astype(x.dtype)
        y_att = (att * jax.nn.silu(z_att)) @ w_o_att[l]
        ssm = s5_branch(u, ssm_lambda_re[l], ssm_lambda_im[l], ssm_log_dt[l], ssm_b_re[l], ssm_b_im[l],
                        ssm_c_re[l], ssm_c_im[l], ssm_d[l], w_glu[l], b_glu[l])
        y_ssm = (ssm * jax.nn.silu(z_ssm)) @ w_o_ssm[l]
        merged = jax.nn.sigmoid(g_att) * y_att + jax.nn.sigmoid(g_ssm) * y_ssm
        x = x + (merged @ w_out[l]).astype(x.dtype)
    return rmsnorm(x, final_g)
```

```cpp
#include <hip/hip_runtime.h>
#include <hip/hip_cooperative_groups.h>
#include <cstdio>
#include <cstdint>
namespace cg = cooperative_groups;
namespace pg8 {
#define PG8_LAS __attribute__((address_space(3)))
typedef unsigned short bf16_t;
typedef short bf16x8 __attribute__((ext_vector_type(8)));
typedef float f32x4 __attribute__((ext_vector_type(4)));
typedef unsigned u32x4 __attribute__((ext_vector_type(4)));
constexpr int BM = 256, BK = 64, HALF = 128, HTB = HALF * BK * 2  , STAGE_BYTES = 8 * HTB, NXCD = 8, WGM = 8;

__host__ __device__ __forceinline__ int lds_byte(int r, int c) { const int st = (r >> 4) * 2 + (c >> 5), rr = r & 15, cc = c & 31, ob = rr * 64 + cc * 2; return st * 1024 + (ob ^ (((ob >> 9) & 1) << 5)); }
__host__ __device__ __forceinline__ void stage_rc(int b, int& R, int& C) { const int st = b / 1024, sb = b % 1024, swz = sb ^ (((sb >> 9) & 1) << 5); R = (st >> 1) * 16 + swz / 64; C = (st & 1) * 32 + (swz % 64) / 2; }
__host__ __device__ __forceinline__ int perm32(int rho) { const int n = rho >> 4, i = rho & 15; return 8 * (i >> 2) + 4 * n + (i & 3); }

struct Unit { int pm, pn; };
struct Gemm { const bf16_t* A; const bf16_t* Bt; int M, N, K; };
struct StaticOrder {
    int nM, nN, nwg, G, c, wgm;
    __host__ __device__ void init(int M, int N, int G_, int c_, int wgm_ = WGM) { nM = M / BM; nN = N / BM; nwg = nM * nN; G = G_; c = c_; wgm = wgm_; }
    __host__ __device__ bool next(int i, Unit& u) const {
        const long L = (long)i * G + c; if (L >= nwg) return false;
        int wgid = (int)L; { const int q = nwg / NXCD, r = nwg % NXCD, xcd = wgid % NXCD, off = wgid / NXCD; wgid = (xcd < r ? xcd * (q + 1) : r * (q + 1) + (xcd - r) * q) + off; }
        const int nig = wgm * nN, gid = wgid / nig, fm = gid * wgm, gsz = (nM - fm) < wgm ? (nM - fm) : wgm;
        u.pm = fm + ((wgid % nig) % gsz); u.pn = (wgid % nig) / gsz; return true;
    }
    __device__ __forceinline__ void a_ready(const Unit&) const {}
    __device__ __forceinline__ void done(const Unit&) const {}
};
__device__ __forceinline__ unsigned cvt_pk_bf16(float lo, float hi) { unsigned r; asm volatile("v_cvt_pk_bf16_f32 %0, %1, %2" : "=v"(r) : "v"(lo), "v"(hi)); return r; }
typedef float f32x2 __attribute__((ext_vector_type(2)));
template <class Epi, class Sched, bool ALIGN_EPI = false, bool SP2 = false>
__device__ __forceinline__ void gemm_phase(PG8_LAS unsigned char* lds, const Gemm g, const Sched& S, const Epi& E) {
    const int tid = threadIdx.x, wid = __builtin_amdgcn_readfirstlane(tid >> 6), lane = tid & 63, wr = wid >> 2, wc = wid & 3, fr = lane & 15, fq = lane >> 4;
    const int K = g.K, nt = K / BK;
    unsigned voffA[2], voffB[2];
#pragma unroll
    for (int i = 0; i < 2; ++i) { int R, C; stage_rc(tid * 16 + i * 8192, R, C); const int Rb = Epi::PERM ? ((R & ~31) + perm32(R & 31)) : R;
        voffA[i] = (unsigned)(R * K + C) * 2u; voffB[i] = (unsigned)(Rb * K + C) * 2u; }
    const size_t kstep = (size_t)(BK * 2);
    const size_t hstep = (size_t)HALF * K * 2;
    const size_t tstep = 2 * hstep;
    const unsigned ldsw = (unsigned)wid * 1024u;
    const int aoff = lds_byte(wr * 64 + fr, fq * 8), boff = lds_byte(wc * 32 + fr, fq * 8);
#define PG8_SA(b, h) (((b) * 2 + (h)) * HTB)
#define PG8_SB(b, h) ((4 + (b) * 2 + (h)) * HTB)
#define PG8_STAGE(bufoff, gbase, voff) do { _Pragma("unroll") for (int _i = 0; _i < 2; ++_i) \
        __builtin_amdgcn_global_load_lds((const unsigned*)((const char*)(gbase) + (voff)[_i]), (PG8_LAS unsigned*)(lds + (bufoff) + ldsw + _i * 8192), 16, 0, 0); } while (0)
#define PG8_LDA(dst, b, h) do { _Pragma("unroll") for (int m = 0; m < 4; ++m) _Pragma("unroll") for (int k = 0; k < 2; ++k) dst[m][k] = *(const PG8_LAS bf16x8*)(lds + PG8_SA(b, h) + aoff + m * 2048 + k * 1024); } while (0)
#define PG8_LDB(dst, b, h) do { _Pragma("unroll") for (int n = 0; n < 2; ++n) _Pragma("unroll") for (int k = 0; k < 2; ++k) dst[n][k] = *(const PG8_LAS bf16x8*)(lds + PG8_SB(b, h) + boff + n * 2048 + k * 1024); } while (0)
#define PG8_MMA(ai, bj, At, Bt) do { __builtin_amdgcn_s_setprio(1); _Pragma("unroll") for (int m = 0; m < 4; ++m) _Pragma("unroll") for (int n = 0; n < 2; ++n) _Pragma("unroll") for (int k = 0; k < 2; ++k) \
        acc[ai][bj][m][n] = __builtin_amdgcn_mfma_f32_16x16x32_bf16(Bt[n][k], At[m][k], acc[ai][bj][m][n], 0, 0, 0); __builtin_amdgcn_s_setprio(0); } while (0)
#define PG8_WAIT_V(n) asm volatile("s_waitcnt vmcnt(" #n ")" ::: "memory")
#define PG8_WAIT_L(n) asm volatile("s_waitcnt lgkmcnt(" #n ")" ::: "memory")
#define PG8_BAR __builtin_amdgcn_s_barrier()
#define PG8_SCHED __builtin_amdgcn_sched_barrier(0)
    Unit cur, nxt; int ui = 0;
    if (!S.next(0, cur)) return;
    f32x4 acc[2][2][4][2];
#pragma unroll
    for (int a = 0; a < 2; ++a)
#pragma unroll
        for (int b = 0; b < 2; ++b)
#pragma unroll
            for (int m = 0; m < 4; ++m)
#pragma unroll
                for (int n = 0; n < 2; ++n) acc[a][b][m][n] = (f32x4){0.f, 0.f, 0.f, 0.f};
    bf16x8 At[4][2], B0[2][2], B1[2][2];
    const char* cA = (const char*)g.A + (size_t)cur.pm * tstep; const char* cB = (const char*)g.Bt + (size_t)cur.pn * tstep;
    S.a_ready(cur);
    if constexpr (SP2) {
        PG8_STAGE(PG8_SB(0, 0), cB, voffB); PG8_STAGE(PG8_SB(0, 1), cB + hstep, voffB); PG8_STAGE(PG8_SA(0, 0), cA, voffA); PG8_STAGE(PG8_SA(0, 1), cA + hstep, voffA);
        if (wr == 1) PG8_BAR;
        PG8_WAIT_V(2); PG8_BAR;
        PG8_STAGE(PG8_SB(1, 0), cB + kstep, voffB); PG8_STAGE(PG8_SA(1, 0), cA + kstep, voffA); PG8_STAGE(PG8_SB(1, 1), cB + hstep + kstep, voffB);
        PG8_WAIT_V(6); PG8_BAR;
    } else {
        PG8_STAGE(PG8_SB(0, 0), cB, voffB); PG8_STAGE(PG8_SA(0, 0), cA, voffA); PG8_STAGE(PG8_SB(0, 1), cB + hstep, voffB); PG8_STAGE(PG8_SA(0, 1), cA + hstep, voffA);
        if (wr == 1) PG8_BAR;
        PG8_WAIT_V(4); PG8_BAR;
        PG8_STAGE(PG8_SB(1, 0), cB + kstep, voffB); PG8_STAGE(PG8_SA(1, 0), cA + kstep, voffA); PG8_STAGE(PG8_SB(1, 1), cB + hstep + kstep, voffB);
        PG8_WAIT_V(6); PG8_BAR;
    }
    for (;;) {
        const bool has_next = S.next(ui + 1, nxt);
        const char* nA = has_next ? (const char*)g.A + (size_t)nxt.pm * tstep : cA; const char* nB = has_next ? (const char*)g.Bt + (size_t)nxt.pn * tstep : cB;
        for (int t = 0; t < nt; t += 2) {
            const bool last = (t == nt - 2);
            const char* a1 = cA + (size_t)(t + 1) * kstep;
            const char* a2 = last ? nA : cA + (size_t)(t + 2) * kstep; const char* b2 = last ? nB : cB + (size_t)(t + 2) * kstep;
            const char* a3 = a2 + kstep; const char* b3 = b2 + kstep;
            if (last && has_next) S.a_ready(nxt);
            if constexpr (SP2) {
            PG8_LDB(B0, 0, 0); PG8_LDB(B1, 0, 1); PG8_SCHED; PG8_LDA(At, 0, 0); PG8_STAGE(PG8_SA(1, 1), a1 + hstep, voffA);
            PG8_WAIT_V(8); PG8_WAIT_L(0); PG8_BAR; PG8_MMA(0, 0, At, B0); PG8_MMA(0, 1, At, B1); PG8_BAR; PG8_SCHED;
            PG8_LDA(At, 0, 1); PG8_STAGE(PG8_SB(0, 0), b2, voffB); PG8_STAGE(PG8_SB(0, 1), b2 + hstep, voffB); PG8_STAGE(PG8_SA(0, 0), a2, voffA);
            PG8_WAIT_V(8); PG8_WAIT_L(0); PG8_BAR; PG8_MMA(1, 0, At, B0); PG8_MMA(1, 1, At, B1); PG8_BAR; PG8_SCHED;
            PG8_LDB(B0, 1, 0); PG8_LDB(B1, 1, 1); PG8_SCHED; PG8_LDA(At, 1, 0); PG8_STAGE(PG8_SA(0, 1), a2 + hstep, voffA);
            PG8_WAIT_V(8); PG8_WAIT_L(0); PG8_BAR; PG8_MMA(0, 0, At, B0); PG8_MMA(0, 1, At, B1); PG8_BAR; PG8_SCHED;
            PG8_LDA(At, 1, 1); PG8_STAGE(PG8_SB(1, 0), b3, voffB); PG8_STAGE(PG8_SB(1, 1), b3 + hstep, voffB); PG8_STAGE(PG8_SA(1, 0), a3, voffA);
            PG8_WAIT_V(8); PG8_WAIT_L(0); PG8_BAR; PG8_MMA(1, 0, At, B0); PG8_MMA(1, 1, At, B1); PG8_BAR; PG8_SCHED;
            } else {
            PG8_LDB(B0, 0, 0); PG8_SCHED; PG8_LDA(At, 0, 0); PG8_STAGE(PG8_SA(1, 1), a1 + hstep, voffA);
            PG8_WAIT_L(8); PG8_BAR; PG8_WAIT_L(0); PG8_MMA(0, 0, At, B0); PG8_BAR; PG8_SCHED;
            PG8_LDB(B1, 0, 1); PG8_STAGE(PG8_SB(0, 0), b2, voffB);
            PG8_BAR; PG8_WAIT_L(0); PG8_MMA(0, 1, At, B1); PG8_BAR;
            PG8_LDA(At, 0, 1); PG8_STAGE(PG8_SA(0, 0), a2, voffA);
            PG8_BAR; PG8_WAIT_L(0); PG8_MMA(1, 0, At, B0); PG8_BAR; PG8_SCHED;
            PG8_STAGE(PG8_SB(0, 1), b2 + hstep, voffB);
            PG8_WAIT_V(6); PG8_BAR; PG8_MMA(1, 1, At, B1); PG8_BAR;
            PG8_LDB(B0, 1, 0); PG8_SCHED; PG8_LDA(At, 1, 0); PG8_STAGE(PG8_SA(0, 1), a2 + hstep, voffA);
            PG8_WAIT_L(8); PG8_BAR; PG8_WAIT_L(0); PG8_MMA(0, 0, At, B0); PG8_BAR; PG8_SCHED;
            PG8_LDB(B1, 1, 1); PG8_STAGE(PG8_SB(1, 0), b3, voffB);
            PG8_BAR; PG8_WAIT_L(0); PG8_MMA(0, 1, At, B1); PG8_BAR;
            PG8_LDA(At, 1, 1); PG8_STAGE(PG8_SA(1, 0), a3, voffA);
            PG8_BAR; PG8_WAIT_L(0); PG8_MMA(1, 0, At, B0); PG8_BAR; PG8_SCHED;
            PG8_STAGE(PG8_SB(1, 1), b3 + hstep, voffB);
            PG8_WAIT_V(6); PG8_BAR; PG8_MMA(1, 1, At, B1); PG8_BAR;
            }
        }
        if constexpr (ALIGN_EPI) { if (wr == 0) PG8_BAR; }
        if constexpr (!Epi::AFTER_DRAIN) { E(acc, cur, wr, wc, fr, fq); S.done(cur); }
        if (!has_next) break;
#pragma unroll
        for (int a = 0; a < 2; ++a)
#pragma unroll
            for (int b = 0; b < 2; ++b)
#pragma unroll
                for (int m = 0; m < 4; ++m)
#pragma unroll
                    for (int n = 0; n < 2; ++n) acc[a][b][m][n] = (f32x4){0.f, 0.f, 0.f, 0.f};
        cur = nxt; cA = nA; cB = nB; ++ui;
        if constexpr (ALIGN_EPI) { if (wr == 1) PG8_BAR; }
    }
    PG8_WAIT_V(0);
    if constexpr (!ALIGN_EPI) { if (wr == 0) PG8_BAR; }
    PG8_BAR;
    if constexpr (Epi::AFTER_DRAIN) { E.fused(acc, cur, wr, wc, fr, fq, lds, wid, lane); S.done(cur); }
#undef PG8_SA
#undef PG8_SB
#undef PG8_STAGE
#undef PG8_LDA
#undef PG8_LDB
#undef PG8_MMA
#undef PG8_WAIT_V
#undef PG8_WAIT_L
#undef PG8_BAR
#undef PG8_SCHED
}
}

using pg8::bf16_t; using pg8::bf16x8; using pg8::f32x4; using pg8::u32x4; using pg8::Unit; using pg8::cvt_pk_bf16;
#define LAS __attribute__((address_space(3)))
typedef float f32x16 __attribute__((ext_vector_type(16)));
typedef float f32x2v __attribute__((ext_vector_type(2)));
typedef short s16x4 __attribute__((ext_vector_type(4)));
typedef unsigned u32x2 __attribute__((ext_vector_type(2)));
#define MFMA32(a, b, c) __builtin_amdgcn_mfma_f32_32x32x16_bf16((a), (b), (c), 0, 0, 0)

constexpr int T = 32768, SEQ = 2048, DM = 1024, NIN = 7168, SW = 512;
constexpr size_t MiB = 1u << 20;
constexpr size_t WS_ROWSQ = 0;
constexpr size_t WS_BAR = 512 * 1024;
constexpr size_t WS_QCTR = WS_BAR + 24576, WS_KMAX = WS_BAR + 24576 + 64;
constexpr size_t WS_CNT = WS_BAR + 16384;
constexpr size_t WS_WIN = 2 * MiB, WS_WOATT = 16 * MiB, WS_WGLU = 18 * MiB, WS_WOSSM = 19 * MiB, WS_WOUT = 20 * MiB;
constexpr size_t WS_LBAR = 22 * MiB, WS_LB256 = 22 * MiB + 32 * 1024, WS_BB = 22 * MiB + 64 * 1024, WS_CM = 22 * MiB + 256 * 1024;
constexpr size_t WS_YS = 24 * MiB;
constexpr size_t WS_PROJ = 64 * MiB;
constexpr size_t WS_END = 512 * MiB;
constexpr size_t PQ = 0, PK = (size_t)T * 1024, PV = 2 * (size_t)T * 1024, PSZA = 3 * (size_t)T * 1024, PU = 4 * (size_t)T * 1024,
                 PSZS = PU + (size_t)T * 512, PGA = 5 * (size_t)T * 1024, PGS = 6 * (size_t)T * 1024;
constexpr size_t PS = PQ, PY1 = PK, PMG = PV;
constexpr int LDS_BYTES = 147456;
constexpr float C2 = 0.125f * 1.4426950408889634f;
constexpr float EPS = 1e-5f;

__device__ __forceinline__ unsigned f2bf(float f) { unsigned u = __builtin_bit_cast(unsigned, f); return (u + 0x7fffu + ((u >> 16) & 1u)) >> 16; }
__device__ __forceinline__ unsigned pk2(float lo, float hi) { return f2bf(lo) | (f2bf(hi) << 16); }
__device__ __forceinline__ float bflo(unsigned w) { return __builtin_bit_cast(float, w << 16); }
__device__ __forceinline__ float bfhi(unsigned w) { return __builtin_bit_cast(float, w & 0xffff0000u); }
__device__ __forceinline__ float sigm(float x) { return __builtin_amdgcn_rcpf(1.f + __expf(-x)); }
__device__ __forceinline__ float wave_sum(float v) {
#pragma unroll
    for (int o = 1; o < 64; o <<= 1) v += __shfl_xor(v, o);
    return v;
}
__device__ __forceinline__ u32x4 pack8(const f32x4& a, const f32x4& b) { u32x4 w; w.x = cvt_pk_bf16(a[0], a[1]); w.y = cvt_pk_bf16(a[2], a[3]); w.z = cvt_pk_bf16(b[0], b[1]); w.w = cvt_pk_bf16(b[2], b[3]); return w; }
__device__ __forceinline__ void unpack8(const u32x4& w, f32x4& a, f32x4& b) { a = (f32x4){bflo(w.x), bfhi(w.x), bflo(w.y), bfhi(w.y)}; b = (f32x4){bflo(w.z), bfhi(w.z), bflo(w.w), bfhi(w.w)}; }

struct EpiProj {
    static constexpr bool PERM = true, AFTER_DRAIN = false;
    bf16_t* proj; unsigned* kmax;
    __device__ __forceinline__ void operator()(const f32x4 (&acc)[2][2][4][2], const Unit& u, int wr, int wc, int fr, int fq) const {
        const int colt = u.pn * 256; int start, pitch, act; size_t off;
        if (colt < 1024) { start = 0; pitch = 1024; off = PQ; act = 3; }
        else if (colt < 2048) { start = 1024; pitch = 1024; off = PK; act = 4; }
        else if (colt < 3072) { start = 2048; pitch = 1024; off = PV; act = 0; }
        else if (colt < 4096) { start = 3072; pitch = 1024; off = PSZA; act = 1; }
        else if (colt < 4608) { start = 4096; pitch = 512; off = PU; act = 0; }
        else if (colt < 5120) { start = 4608; pitch = 512; off = PSZS; act = 1; }
        else if (colt < 6144) { start = 5120; pitch = 1024; off = PGA; act = 2; }
        else { start = 6144; pitch = 1024; off = PGS; act = 2; }
        const int row0 = u.pm * 256 + wr * 64 + fr, col0 = colt - start + wc * 32 + 8 * fq;
        bf16_t* base = proj + off; float kn = 0.f;
#pragma unroll
        for (int ai = 0; ai < 2; ++ai)
#pragma unroll
            for (int m = 0; m < 4; ++m) { bf16_t* rowp = base + (size_t)(row0 + ai * 128 + m * 16) * pitch + col0;
#pragma unroll
                for (int bj = 0; bj < 2; ++bj) { f32x4 v0 = acc[ai][bj][m][0], v1 = acc[ai][bj][m][1];
                    if (act == 1) {
#pragma unroll
                        for (int e = 0; e < 4; ++e) { v0[e] = v0[e] * sigm(v0[e]); v1[e] = v1[e] * sigm(v1[e]); } }
                    else if (act == 2) {
#pragma unroll
                        for (int e = 0; e < 4; ++e) { v0[e] = sigm(v0[e]); v1[e] = sigm(v1[e]); } }
                    else if (act == 3) { v0 = v0 * C2; v1 = v1 * C2; }
                    else if (act == 4) { float ss = (v0[0] * v0[0] + v0[1] * v0[1]) + (v0[2] * v0[2] + v0[3] * v0[3]) + (v1[0] * v1[0] + v1[1] * v1[1]) + (v1[2] * v1[2] + v1[3] * v1[3]);
                        ss += __shfl_xor(ss, 16); ss += __shfl_xor(ss, 32); kn = fmaxf(kn, ss); }
                    *(u32x4*)(rowp + bj * 128) = pack8(v0, v1); } }
        if (act == 4) {
#pragma unroll
            for (int o = 1; o < 16; o <<= 1) kn = fmaxf(kn, __shfl_xor(kn, o));
            if ((threadIdx.x & 63) == 0) atomicMax(kmax, __builtin_bit_cast(unsigned, kn));
        }
    }
};
struct EpiGlu {
    static constexpr bool PERM = true, AFTER_DRAIN = false;
    const bf16_t* ys; const bf16_t* szs; const float* bglu; bf16_t* S;
    __device__ __forceinline__ void operator()(const f32x4 (&acc)[2][2][4][2], const Unit& u, int wr, int wc, int fr, int fq) const {
        const int row0 = u.pm * 256 + wr * 64 + fr, col0 = u.pn * 256 + wc * 32 + 8 * fq;
#pragma unroll
        for (int ai = 0; ai < 2; ++ai)
#pragma unroll
            for (int m = 0; m < 4; ++m) { const size_t ro = (size_t)(row0 + ai * 128 + m * 16) * 512 + col0;
#pragma unroll
                for (int bj = 0; bj < 2; ++bj) { const size_t o = ro + bj * 128;
                    const f32x4 b0 = *(const f32x4*)(bglu + col0 + bj * 128), b1 = *(const f32x4*)(bglu + col0 + bj * 128 + 4);
                    f32x4 y0, y1, z0, z1; unpack8(*(const u32x4*)(ys + o), y0, y1); unpack8(*(const u32x4*)(szs + o), z0, z1);
                    f32x4 v0 = acc[ai][bj][m][0] + b0, v1 = acc[ai][bj][m][1] + b1;
#pragma unroll
                    for (int e = 0; e < 4; ++e) { v0[e] = y0[e] * sigm(v0[e]) * z0[e]; v1[e] = y1[e] * sigm(v1[e]) * z1[e]; }
                    *(u32x4*)(S + o) = pack8(v0, v1); } }
    }
};
template <int MODE> struct EpiGate {
    static constexpr bool PERM = true, AFTER_DRAIN = false;
    const bf16_t* gate; const bf16_t* y1; bf16_t* O;
    __device__ __forceinline__ void operator()(const f32x4 (&acc)[2][2][4][2], const Unit& u, int wr, int wc, int fr, int fq) const {
        const int row0 = u.pm * 256 + wr * 64 + fr, col0 = u.pn * 256 + wc * 32 + 8 * fq;
#pragma unroll
        for (int ai = 0; ai < 2; ++ai)
#pragma unroll
            for (int m = 0; m < 4; ++m) { const size_t ro = (size_t)(row0 + ai * 128 + m * 16) * 1024 + col0;
#pragma unroll
                for (int bj = 0; bj < 2; ++bj) { const size_t o = ro + bj * 128;
                    f32x4 g0, g1; unpack8(*(const u32x4*)(gate + o), g0, g1);
                    f32x4 v0 = acc[ai][bj][m][0] * g0, v1 = acc[ai][bj][m][1] * g1;
                    if (MODE == 1) { f32x4 p0, p1; unpack8(*(const u32x4*)(y1 + o), p0, p1); v0 += p0; v1 += p1; }
                    *(u32x4*)(O + o) = pack8(v0, v1); } }
    }
};
struct EpiOutNorm {
    static constexpr bool PERM = true, AFTER_DRAIN = false;
    const float* x; float* out; float* rowsq; unsigned* cnt; const float* fg;
    __device__ __forceinline__ void operator()(const f32x4 (&acc_c)[2][2][4][2], const Unit& u, int wr, int wc, int fr, int fq) const {
        f32x4 (&acc)[2][2][4][2] = const_cast<f32x4 (&)[2][2][4][2]>(acc_c);
        const int row0 = u.pm * 256 + wr * 64 + fr, col0 = u.pn * 256 + wc * 32 + 8 * fq;
        float olds[8];
#pragma unroll
        for (int e = 0; e < 8; ++e) olds[e] = 0.f;
#pragma unroll
        for (int ai = 0; ai < 2; ++ai)
#pragma unroll
            for (int m = 0; m < 4; ++m) { const int row = row0 + ai * 128 + m * 16; const size_t ro = (size_t)row * 1024 + col0; float ss = 0.f;
#pragma unroll
                for (int bj = 0; bj < 2; ++bj) { const size_t o = ro + bj * 128;
                    const f32x4 r0 = *(const f32x4*)(x + o) + acc[ai][bj][m][0], r1 = *(const f32x4*)(x + o + 4) + acc[ai][bj][m][1];
                    acc[ai][bj][m][0] = r0; acc[ai][bj][m][1] = r1;
                    ss += (r0[0] * r0[0] + r0[1] * r0[1]) + (r0[2] * r0[2] + r0[3] * r0[3]) + (r1[0] * r1[0] + r1[1] * r1[1]) + (r1[2] * r1[2] + r1[3] * r1[3]); }
                ss += __shfl_xor(ss, 16); ss += __shfl_xor(ss, 32);
                if (fq == 0) olds[ai * 4 + m] = unsafeAtomicAdd(rowsq + row, ss); }
        asm volatile("s_waitcnt vmcnt(0)" :: "v"(olds[0]), "v"(olds[1]), "v"(olds[2]), "v"(olds[3]), "v"(olds[4]), "v"(olds[5]), "v"(olds[6]), "v"(olds[7]) : "memory");
        unsigned* c = cnt + u.pm * 16;
        if ((threadIdx.x & 63) == 0) __hip_atomic_fetch_add(c, 1u, __ATOMIC_RELAXED, __HIP_MEMORY_SCOPE_AGENT);
        { unsigned sp = 0; while (__hip_atomic_load(c, __ATOMIC_RELAXED, __HIP_MEMORY_SCOPE_AGENT) < 32u) { __builtin_amdgcn_s_sleep(4); if (++sp > (1u << 22)) break; } }
        asm volatile("s_waitcnt vmcnt(0)" ::: "memory");
        f32x4 g[2][2];
#pragma unroll
        for (int bj = 0; bj < 2; ++bj) { g[bj][0] = *(const f32x4*)(fg + col0 + bj * 128); g[bj][1] = *(const f32x4*)(fg + col0 + bj * 128 + 4); }
#pragma unroll
        for (int ai = 0; ai < 2; ++ai)
#pragma unroll
            for (int m = 0; m < 4; ++m) { const int row = row0 + ai * 128 + m * 16; const size_t ro = (size_t)row * 1024 + col0;
                const float rs = 1.f / sqrtf(__hip_atomic_load(rowsq + row, __ATOMIC_RELAXED, __HIP_MEMORY_SCOPE_AGENT) * (1.f / 1024) + EPS);
#pragma unroll
                for (int bj = 0; bj < 2; ++bj) { const size_t o = ro + bj * 128;
                    *(f32x4*)(out + o) = acc[ai][bj][m][0] * rs * g[bj][0]; *(f32x4*)(out + o + 4) = acc[ai][bj][m][1] * rs * g[bj][1]; } }
    }
};

__device__ __forceinline__ void transpose_item(const float* W, int K, int N, const float* gk, bf16_t* WT, LAS float* scr, int item, int lane) {
    const int nblk = N / 32, kb = item / nblk, nb = item % nblk, k0 = 64 * kb, n0 = 32 * nb;
#pragma unroll 8
    for (int i = 0; i < 32; ++i) { const int kk = 2 * i + (lane >> 5); float v = W[(size_t)(k0 + kk) * N + n0 + (lane & 31)]; if (gk) v *= gk[k0 + kk]; scr[kk * 33 + (lane & 31)] = v; }
    asm volatile("s_waitcnt lgkmcnt(0)" ::: "memory");
    const int c = lane & 7;
#pragma unroll
    for (int j = 0; j < 4; ++j) { const int n = (lane >> 3) + 8 * j; const LAS float* s = scr + (8 * c) * 33 + n;
        u32x4 o; o.x = pk2(s[0 * 33], s[1 * 33]); o.y = pk2(s[2 * 33], s[3 * 33]); o.z = pk2(s[4 * 33], s[5 * 33]); o.w = pk2(s[6 * 33], s[7 * 33]);
        *(u32x4*)(WT + (size_t)(n0 + n) * K + k0 + 8 * c) = o; }
    asm volatile("s_waitcnt lgkmcnt(0)" ::: "memory");
}
__device__ __forceinline__ void sincos_small(double r, double& s, double& c) {
    const double r2 = r * r;
    s = r * (1.0 + r2 * (-1.0 / 6 + r2 * (1.0 / 120 + r2 * (-1.0 / 5040 + r2 * (1.0 / 362880 + r2 * (-1.0 / 39916800 + r2 * (1.0 / 6227020800.0)))))));
    c = 1.0 + r2 * (-0.5 + r2 * (1.0 / 24 + r2 * (-1.0 / 720 + r2 * (1.0 / 40320 + r2 * (-1.0 / 3628800 + r2 * (1.0 / 479001600.0 + r2 * (-1.0 / 87178291200.0)))))));
}
__device__ __forceinline__ void sincos_d(double th, double& s, double& c) {
    const double PI2 = 1.5707963267948966192313216916398;
    const double k = rint(th / PI2); const double r = th - k * PI2;
    double sr, cr; sincos_small(r, sr, cr);
    const int q = ((int)k) & 3;
    if (q == 0) { s = sr; c = cr; } else if (q == 1) { s = cr; c = -sr; } else if (q == 2) { s = -sr; c = -cr; } else { s = -cr; c = sr; }
}
__device__ __forceinline__ double exp_d(double x) {
    const double y = x * (1.0 / 256);
    double e = 1.0 + y * (1.0 + y * (0.5 + y * (1.0 / 6 + y * (1.0 / 24 + y * (1.0 / 120 + y * (1.0 / 720 + y * (1.0 / 5040 + y * (1.0 / 40320 + y * (1.0 / 362880 + y * (1.0 / 3628800))))))))));
    e *= e; e *= e; e *= e; e *= e; e *= e; e *= e; e *= e; e *= e; return e;
}
#define XB_TMO      128
#define XB_XCNT(j)  (256  + 64 * (j))
#define XB_XSUB(j)  (1280 + 64 * (j))
#define XB_XGEN(j)  (2304 + 64 * (j))
#define XB_TOP      3328
#define XB_TOPGEN   3392
#define XCD_BAR_WORDS 3456
#define XB_SPIN_CAP (1u << 18)

__device__ __forceinline__ unsigned xb_ld(unsigned* p)              { return __hip_atomic_load(p, __ATOMIC_RELAXED, __HIP_MEMORY_SCOPE_AGENT); }
__device__ __forceinline__ unsigned xb_add(unsigned* p, unsigned v) { return __hip_atomic_fetch_add(p, v, __ATOMIC_RELAXED, __HIP_MEMORY_SCOPE_AGENT); }
__device__ __forceinline__ unsigned xb_xcc_id() { return (unsigned)__builtin_amdgcn_s_getreg((3 << 11) | 20) & 0xFu; }
#define XB_SPIN(cond, bar) do { unsigned _sp = 0; while (cond) { __builtin_amdgcn_s_sleep(1); \
    if ((++_sp & 255u) == 0u) { if (xb_ld(&(bar)[XB_TMO])) break; if (_sp > XB_SPIN_CAP) { atomicAdd(&(bar)[XB_TMO], 1u); break; } } } } while (0)

struct XcdBarrier {
    unsigned* bar; unsigned x;
    volatile LAS unsigned* st;
};

__device__ __forceinline__ XcdBarrier xcd_barrier_post(unsigned* bar, volatile LAS unsigned* st) {
    XcdBarrier b; b.bar = bar; b.x = xb_xcc_id(); b.st = st;
    if (threadIdx.x == 0) (void)xb_add(&bar[XB_XCNT(b.x)], 1u);
    return b;
}
__device__ __forceinline__ void xcd_barrier_complete(unsigned* bar, unsigned x, unsigned& nloc, unsigned& nx) {
    const unsigned G = gridDim.x * gridDim.y * gridDim.z;
    unsigned sum, cnt, mine, sp = 0u;
    for (;;) {
        sum = 0u; cnt = 0u; mine = 0u;
#pragma unroll
        for (unsigned j = 0; j < 16; ++j) { const unsigned c = xb_ld(&bar[XB_XCNT(j)]); sum += c; cnt += (c > 0u) ? 1u : 0u; mine = (j == x) ? c : mine; }
        if (sum == G) break;
        __builtin_amdgcn_s_sleep(1);
        if ((++sp & 255u) == 0u) { if (xb_ld(&bar[XB_TMO])) break; if (sp > XB_SPIN_CAP) { atomicAdd(&bar[XB_TMO], 1u); break; } }
    }
    nloc = mine > 0u ? mine : 1u; nx = cnt > 0u ? cnt : 1u;
}

__device__ __forceinline__ void xcd_barrier(const XcdBarrier& b) {
    asm volatile("s_waitcnt vmcnt(0)" ::: "memory");
    __syncthreads();
    if (threadIdx.x == 0) {
        unsigned* bar = b.bar;
        __builtin_amdgcn_s_waitcnt(0);
        unsigned nloc = b.st[0], nx = b.st[1];
        if (nloc == 0u) { xcd_barrier_complete(bar, b.x, nloc, nx); b.st[0] = nloc; b.st[1] = nx; }
        const unsigned old = xb_add(&bar[XB_XSUB(b.x)], 1u);
        const unsigned gen = old / nloc;
        if (old + 1u == (gen + 1u) * nloc) {
            __builtin_amdgcn_fence(__ATOMIC_RELEASE, "agent");
            asm volatile("s_waitcnt vmcnt(0)" ::: "memory");
            const unsigned og = xb_add(&bar[XB_TOP], 1u);
            const unsigned tg = og / nx;
            if (og + 1u == (tg + 1u) * nx) xb_add(&bar[XB_TOPGEN], 1u);
            else XB_SPIN(xb_ld(&bar[XB_TOPGEN]) == tg, bar);
            __builtin_amdgcn_fence(__ATOMIC_ACQUIRE, "agent");
            xb_add(&bar[XB_XGEN(b.x)], 1u);
            asm volatile("s_waitcnt vmcnt(0)" ::: "memory");
        } else {
            XB_SPIN(xb_ld(&bar[XB_XGEN(b.x)]) == gen, bar);
            __builtin_amdgcn_fence(__ATOMIC_ACQUIRE, "agent");
            asm volatile("s_waitcnt vmcnt(0)" ::: "memory");
        }
    }
    __syncthreads();
}

struct Args { const float* in[22]; float* out; unsigned char* ws; int ph_lo, ph_hi; };

__device__ __forceinline__ void p0_prologue(const Args& a, LAS unsigned char* lds, int vcu, int G) {
    const int tid = threadIdx.x, lane = tid & 63, wave = tid >> 6;
    unsigned char* ws = a.ws;
    LAS float* scr = (LAS float*)(lds + wave * 16384);
    const int gw = vcu * 8 + wave, NGW = G * 8;
    constexpr int I_IN = 16 * 224, I_OA = 16 * 32, I_GL = 8 * 16, I_OS = 8 * 32, I_OUT = 16 * 32;
    constexpr int NITEMS = I_IN + I_OA + I_GL + I_OS + I_OUT;
    for (int it = gw; it < I_IN; it += NGW) transpose_item(a.in[2], 1024, 7168, a.in[1], (bf16_t*)(ws + WS_WIN), scr, it, lane);
    bf16_t* xb = (bf16_t*)a.out;
    for (int m0 = gw * 4; m0 < T; m0 += NGW * 4) {
        f32x4 v[4][4]; float s[4];
#pragma unroll
        for (int r = 0; r < 4; ++r) { const f32x4* xr = (const f32x4*)(a.in[0] + (size_t)(m0 + r) * 1024) + lane;
#pragma unroll
            for (int j = 0; j < 4; ++j) v[r][j] = xr[64 * j]; }
#pragma unroll
        for (int r = 0; r < 4; ++r) { s[r] = 0.f;
#pragma unroll
            for (int j = 0; j < 4; ++j) s[r] += (v[r][j].x * v[r][j].x + v[r][j].y * v[r][j].y) + (v[r][j].z * v[r][j].z + v[r][j].w * v[r][j].w); }
#pragma unroll
        for (int o = 1; o < 64; o <<= 1) {
#pragma unroll
            for (int r = 0; r < 4; ++r) s[r] += __shfl_xor(s[r], o); }
#pragma unroll
        for (int r = 0; r < 4; ++r) { const float rstd = 1.f / sqrtf(s[r] * (1.f / 1024) + EPS);
            u32x2* o8 = (u32x2*)(xb + (size_t)(m0 + r) * 1024) + lane;
#pragma unroll
            for (int j = 0; j < 4; ++j) { u32x2 w; w.x = pk2(v[r][j].x * rstd, v[r][j].y * rstd); w.y = pk2(v[r][j].z * rstd, v[r][j].w * rstd); o8[64 * j] = w; } }
    }
    const int gt = vcu * 512 + tid, NGT = G * 512;
    for (int e = gt; e < 32 * 64 * 16; e += NGT) {
        const int it = e >> 4, h = e & 15, g = it >> 6, p = it & 63;
        const double dt = exp_d((double)a.in[11][g]);
        double lre = (double)a.in[9][it]; if (lre > -1e-4) lre = -1e-4;
        const double lim = (double)a.in[10][it];
        const double mag = exp_d(lre * dt); double sn, cs; sincos_d(lim * dt, sn, cs);
        const double lbr = mag * cs, lbi = mag * sn, nre = lbr - 1.0, den = lre * lre + lim * lim;
        const double cre = (nre * lre + lbi * lim) / den, cim = (lbi * lre - nre * lim) / den;
        if (h == 0) {
            float* lb = (float*)(ws + WS_LBAR); lb[2 * it] = (float)lbr; lb[2 * it + 1] = (float)lbi;
            const double m256 = exp_d(256.0 * lre * dt); double s2, c2; sincos_d(256.0 * lim * dt, s2, c2); float* l2 = (float*)(ws + WS_LB256); l2[2 * it] = (float)(m256 * c2); l2[2 * it + 1] = (float)(m256 * s2);
        }
        bf16_t* Bb = (bf16_t*)(ws + WS_BB); bf16_t* Cm = (bf16_t*)(ws + WS_CM);
        const double bre = (double)a.in[12][(size_t)it * 16 + h], bim = (double)a.in[13][(size_t)it * 16 + h];
        Bb[(size_t)(g * 128 + p) * 16 + h] = (bf16_t)f2bf((float)(cre * bre - cim * bim));
        Bb[(size_t)(g * 128 + 64 + p) * 16 + h] = (bf16_t)f2bf((float)(cre * bim + cim * bre));
        Cm[(size_t)(g * 16 + h) * 128 + p] = (bf16_t)f2bf(a.in[14][(size_t)(g * 16 + h) * 64 + p]);
        Cm[(size_t)(g * 16 + h) * 128 + 64 + p] = (bf16_t)f2bf(-a.in[15][(size_t)(g * 16 + h) * 64 + p]);
    }
    float* rowsq = (float*)(ws + WS_ROWSQ);
    for (int i = gt; i < T; i += NGT) rowsq[i] = 0.f;
}

typedef short v4i16_t __attribute__((ext_vector_type(4)));
__device__ __forceinline__ s16x4 tr16(LAS const unsigned char* p) { return __builtin_bit_cast(s16x4, __builtin_amdgcn_ds_read_tr16_b64_v4i16((LAS v4i16_t*)(LAS unsigned char*)p)); }
__device__ __forceinline__ void ssm_phase(LAS unsigned char* lds, const bf16_t* U, const float* lbar, const float* lb256, const bf16_t* Bb, const bf16_t* Cm, const float* dsk, bf16_t* YS, int unit0, int ustride) {
    const int tid = threadIdx.x, lane = tid & 63, c = lane & 31, hh = lane >> 5, wave = tid >> 6;
    constexpr int IP = 72, IB = 32 * IP, NBLK = 16;
    LAS unsigned char* img = lds + wave * (4 * IB);
    LAS float* ends = (LAS float*)(lds + 8 * 4 * IB);
    const int q_ = (lane & 15) >> 2, p_ = lane & 3, blk_ = (lane >> 4) & 1;
    f32x16 zero;
#pragma unroll
    for (int i = 0; i < 16; ++i) zero[i] = 0.f;
    for (int unit = unit0; unit < 256; unit += ustride) {
        const int g = unit >> 3, bp = unit & 7;
        bf16x8 bfr[4];
#pragma unroll
        for (int cb = 0; cb < 4; ++cb) bfr[cb] = *(const bf16x8*)(Bb + ((size_t)(g * 128 + cb * 32 + c) * 16 + 8 * hh));
        f32x2v ar, ai;
        ar.x = lbar[2 * (g * 64 + c)]; ai.x = lbar[2 * (g * 64 + c) + 1]; ar.y = lbar[2 * (g * 64 + 32 + c)]; ai.y = lbar[2 * (g * 64 + 32 + c) + 1];
        const int seq = (c >> 2) & 1, tau = (c & 3) + 4 * (c >> 3);
        const bf16_t* up = U + ((size_t)((2 * bp + seq) * SEQ + wave * 256 + tau) * 512 + g * 16 + 8 * hh);
        bf16_t* yp = YS + ((size_t)((2 * bp + seq) * SEQ + wave * 256 + tau) * 512 + g * 16 + 4 * hh);
        f32x2v xr = {0.f, 0.f}, xi = {0.f, 0.f};
        {
            bf16x8 a0 = *(const bf16x8*)up, a1 = *(const bf16x8*)(up + 1 * 8192), a2 = *(const bf16x8*)(up + 2 * 8192), a3 = *(const bf16x8*)(up + 3 * 8192);
            for (int blk = 0; blk < NBLK; ++blk) {
                const bf16x8 au = a0; a0 = a1; a1 = a2; a2 = a3; if (blk + 4 < NBLK) a3 = *(const bf16x8*)(up + (size_t)(blk + 4) * 8192);
                f32x16 acc[4];
#pragma unroll
                for (int cb = 0; cb < 4; ++cb) acc[cb] = MFMA32(au, bfr[cb], zero);
#pragma unroll
                for (int i = 0; i < 16; ++i) {
                    const f32x2v br = {acc[0][i], acc[1][i]}, bi = {acc[2][i], acc[3][i]};
                    const f32x2v nr = ar * xr - ai * xi + br, ni = ar * xi + ai * xr + bi;
                    xr = nr; xi = ni;
                }
            }
        }
        ends[(wave * 4 + 0) * 64 + lane] = xr.x; ends[(wave * 4 + 1) * 64 + lane] = xr.y; ends[(wave * 4 + 2) * 64 + lane] = xi.x; ends[(wave * 4 + 3) * 64 + lane] = xi.y;
        __syncthreads();
        {
            f32x2v Lr, Li; Lr.x = lb256[2 * (g * 64 + c)]; Li.x = lb256[2 * (g * 64 + c) + 1]; Lr.y = lb256[2 * (g * 64 + 32 + c)]; Li.y = lb256[2 * (g * 64 + 32 + c) + 1];
            xr = (f32x2v){0.f, 0.f}; xi = (f32x2v){0.f, 0.f};
            for (int i = 0; i < wave; ++i) {
                const f32x2v er = {ends[(i * 4 + 0) * 64 + lane], ends[(i * 4 + 1) * 64 + lane]}, ei = {ends[(i * 4 + 2) * 64 + lane], ends[(i * 4 + 3) * 64 + lane]};
                const f32x2v nr = Lr * xr - Li * xi + er, ni = Lr * xi + Li * xr + ei; xr = nr; xi = ni;
            }
        }
        bf16x8 cfr[8], dhi, dlo;
#pragma unroll
        for (int ks = 0; ks < 8; ++ks) { bf16x8 v = *(const bf16x8*)(Cm + ((size_t)(g * 16 + (c & 15)) * 128 + 16 * ks + 8 * hh));
#pragma unroll
            for (int e = 0; e < 8; ++e) cfr[ks][e] = (c < 16) ? v[e] : (short)0; }
        { const float d = dsk[g * 16 + (c & 15)]; const unsigned dh = f2bf(d); const unsigned dl = f2bf(d - __builtin_bit_cast(float, dh << 16));
          const bool on = (c < 16) && ((c >> 3) == hh);
#pragma unroll
          for (int e = 0; e < 8; ++e) { const bool m = on && (e == (c & 7)); dhi[e] = m ? (short)dh : (short)0; dlo[e] = m ? (short)dl : (short)0; } }
        {
            bf16x8 a0 = *(const bf16x8*)up, a1 = *(const bf16x8*)(up + 1 * 8192), a2 = *(const bf16x8*)(up + 2 * 8192), a3 = *(const bf16x8*)(up + 3 * 8192);
            for (int blk = 0; blk < NBLK; ++blk) {
                const bf16x8 au = a0; a0 = a1; a1 = a2; a2 = a3; if (blk + 4 < NBLK) a3 = *(const bf16x8*)(up + (size_t)(blk + 4) * 8192);
                f32x16 acc[4];
#pragma unroll
                for (int cb = 0; cb < 4; ++cb) acc[cb] = MFMA32(au, bfr[cb], zero);
#pragma unroll
                for (int i = 0; i < 16; ++i) {
                    const f32x2v br = {acc[0][i], acc[1][i]}, bi = {acc[2][i], acc[3][i]};
                    const f32x2v nr = ar * xr - ai * xi + br, ni = ar * xi + ai * xr + bi;
                    xr = nr; xi = ni; acc[0][i] = xr.x; acc[1][i] = xr.y; acc[2][i] = xi.x; acc[3][i] = xi.y;
                }
#pragma unroll
                for (int cb = 0; cb < 4; ++cb)
#pragma unroll
                    for (int g4 = 0; g4 < 4; ++g4) { u32x2 w; w.x = cvt_pk_bf16(acc[cb][4 * g4], acc[cb][4 * g4 + 1]); w.y = cvt_pk_bf16(acc[cb][4 * g4 + 2], acc[cb][4 * g4 + 3]);
                        *(LAS u32x2*)(img + cb * IB + c * IP + 8 * (2 * g4 + hh)) = w; }
                asm volatile("s_waitcnt lgkmcnt(0)" ::: "memory");
                f32x16 Y = MFMA32(dhi, au, zero); Y = MFMA32(dlo, au, Y);
#pragma unroll
                for (int cb = 0; cb < 4; ++cb)
#pragma unroll
                    for (int s = 0; s < 2; ++s) { LAS const unsigned char* rp = img + cb * IB + (16 * s + 8 * hh + q_) * IP + 8 * (4 * blk_ + p_);
                        const s16x4 lo = tr16(rp), hi = tr16(rp + 4 * IP);
                        const bf16x8 xa = __builtin_shufflevector(lo, hi, 0, 1, 2, 3, 4, 5, 6, 7);
                        Y = MFMA32(cfr[cb * 2 + s], xa, Y); }
                asm volatile("s_waitcnt lgkmcnt(0)" ::: "memory");
                { float ge[8];
#pragma unroll
                  for (int i = 0; i < 8; ++i) { const float y = Y[i]; const float z = 1.5957691216057308f * (y + 0.044715f * y * y * y); ge[i] = y * sigm(z); }
                  u32x2 w0, w1; w0.x = cvt_pk_bf16(ge[0], ge[1]); w0.y = cvt_pk_bf16(ge[2], ge[3]); w1.x = cvt_pk_bf16(ge[4], ge[5]); w1.y = cvt_pk_bf16(ge[6], ge[7]);
                  bf16_t* yo = yp + (size_t)(blk * 16) * 512;
                  *(u32x2*)yo = w0; *(u32x2*)(yo + 8) = w1; }
            }
        }
        __syncthreads();
    }
}

__device__ __forceinline__ void attn_tile(const bool FAST, LAS const unsigned char* kb, int kvb, int qa, int hh, int r32, int c, int vrow, int vbyte, float slope2,
                                          const bf16x8 (&qf)[4], f32x16 (&O)[4], float& l, float& Mref, bool& first) {
    constexpr int KP = 272, VP = 320, KBYTES = 64 * KP;
    LAS const unsigned char* vl = kb + KBYTES + vrow * VP + vbyte;
    const float c0 = slope2 * (float)(kvb + 4 * hh - qa) - Mref, c1 = c0 + 32.f * slope2;
    s16x4 va[2][8];
#define VLOAD(set, cb) do { _Pragma("unroll") for (int s = 0; s < 4; ++s) { va[set][2 * s] = tr16(vl + (16 * s) * VP + (cb) * 64); va[set][2 * s + 1] = tr16(vl + (16 * s + 8) * VP + (cb) * 64); } } while (0)
#define VMMA(set, cb) do { _Pragma("unroll") for (int s = 0; s < 4; ++s) { const bf16x8 vf = __builtin_shufflevector(va[set][2 * s], va[set][2 * s + 1], 0, 1, 2, 3, 4, 5, 6, 7); O[cb] = MFMA32(vf, pk[s], O[cb]); } } while (0)
    f32x16 p0, p1;
#pragma unroll
    for (int i = 0; i < 16; ++i) { p0[i] = __builtin_fmaf(slope2, (float)((i & 3) + 8 * (i >> 2)), c0); p1[i] = __builtin_fmaf(slope2, (float)((i & 3) + 8 * (i >> 2)), c1); }
#pragma unroll
    for (int ks = 0; ks < 4; ++ks) { LAS const unsigned char* kp = kb + r32 * KP + (c * 64 + 16 * ks + 8 * hh) * 2;
        const bf16x8 k0 = *(LAS const bf16x8*)kp, k1 = *(LAS const bf16x8*)(kp + 32 * KP);
        p0 = MFMA32(k0, qf[ks], p0); p1 = MFMA32(k1, qf[ks], p1); }
    VLOAD(0, 0);
    if (first) {
#pragma unroll
        for (int i = 0; i < 16; ++i) { const int kv = kvb + 4 * hh + (i & 3) + 8 * (i >> 2); if (kv > qa) p0[i] = -INFINITY; if (kv + 32 > qa) p1[i] = -INFINITY; }
    }
    if (!FAST) {
    float me = fmaxf(p0[0], p1[0]);
#pragma unroll
    for (int i = 1; i < 16; ++i) me = fmaxf(me, fmaxf(p0[i], p1[i]));
    { auto rr = __builtin_amdgcn_permlane32_swap(__float_as_uint(me), __float_as_uint(me), false, false); me = fmaxf(__uint_as_float(rr[0]), __uint_as_float(rr[1])); }
    if (first || __any(me > 8.f)) {
        const float dl = first ? me : fmaxf(me, 0.f); const float f = __builtin_amdgcn_exp2f(-dl);
#pragma unroll
        for (int cb = 0; cb < 4; ++cb) O[cb] = O[cb] * f;
        l *= f; Mref += dl;
#pragma unroll
        for (int i = 0; i < 16; ++i) { p0[i] -= dl; p1[i] -= dl; }
    }
    }
    first = false;
    float sacc = 0.f;
#pragma unroll
    for (int i = 0; i < 16; ++i) { p0[i] = __builtin_amdgcn_exp2f(p0[i]); p1[i] = __builtin_amdgcn_exp2f(p1[i]); sacc += p0[i] + p1[i]; }
    l += sacc;
    bf16x8 pk[4];
#pragma unroll
    for (int s = 0; s < 2; ++s) { u32x4 w0, w1;
        w0.x = cvt_pk_bf16(p0[8 * s], p0[8 * s + 1]); w0.y = cvt_pk_bf16(p0[8 * s + 2], p0[8 * s + 3]); w0.z = cvt_pk_bf16(p0[8 * s + 4], p0[8 * s + 5]); w0.w = cvt_pk_bf16(p0[8 * s + 6], p0[8 * s + 7]);
        w1.x = cvt_pk_bf16(p1[8 * s], p1[8 * s + 1]); w1.y = cvt_pk_bf16(p1[8 * s + 2], p1[8 * s + 3]); w1.z = cvt_pk_bf16(p1[8 * s + 4], p1[8 * s + 5]); w1.w = cvt_pk_bf16(p1[8 * s + 6], p1[8 * s + 7]);
        pk[s] = __builtin_bit_cast(bf16x8, w0); pk[2 + s] = __builtin_bit_cast(bf16x8, w1); }
    __builtin_amdgcn_sched_barrier(0);
    VLOAD(1, 1); __builtin_amdgcn_sched_barrier(0);
    VMMA(0, 0); __builtin_amdgcn_sched_barrier(0);
    VLOAD(0, 2); __builtin_amdgcn_sched_barrier(0);
    VMMA(1, 1); __builtin_amdgcn_sched_barrier(0);
    VLOAD(1, 3); __builtin_amdgcn_sched_barrier(0);
    VMMA(0, 2); __builtin_amdgcn_sched_barrier(0);
    VMMA(1, 3);
#undef VMMA
#undef VLOAD
}

__device__ __forceinline__ void attn_phase(LAS unsigned char* lds, const bf16_t* Q, const bf16_t* Kp, const bf16_t* Vp, const bf16_t* SZ, bf16_t* AG, const float* subln_g, float lam, unsigned* qctr, const unsigned* kmaxp) {
    const int tid = threadIdx.x, lane = tid & 63, r32 = lane & 31, hh = lane >> 5;
    const int wave = __builtin_amdgcn_readfirstlane(tid >> 6), c = wave & 1, j = wave >> 1;
    constexpr int KP = 272, VP = 320, KBYTES = 64 * KP, BUFB = KBYTES + 64 * VP, EXCH = 2 * BUFB;
    static_assert(EXCH + 4 * 16384 + 64 <= LDS_BYTES - 64, "attention LDS");
    const int sr0 = tid >> 4, sch = tid & 15;
    const int vrow = 4 * hh + ((lane & 15) >> 2), vbyte = 32 * ((lane >> 4) & 1) + 8 * (lane & 3);
    const float Kb = sqrtf(2.f * __builtin_bit_cast(float, __hip_atomic_load(kmaxp, __ATOMIC_RELAXED, __HIP_MEMORY_SCOPE_AGENT))) * 1.02f;
    LAS float* dsh = (LAS float*)(lds + EXCH + 4 * 16384);
    LAS int* nxt_slot = (LAS int*)(dsh + 8);
    if (tid == 0) *nxt_slot = (int)atomicAdd(qctr, 1u);
    __syncthreads();
    int cur = *nxt_slot;
    __syncthreads();
    while (cur < 2048) {
        {
            int nxt_reg = 0;
            if (tid == 0) nxt_reg = (int)atomicAdd(qctr, 1u);
            const int qb = 15 - (cur >> 7), bh = cur & 127, b = bh >> 3, h = bh & 7;
            const long rowbase = (long)b * SEQ; const int q0 = qb * 128, NT = 2 * (qb + 1);
            const int qa = q0 + 32 * j + r32;
            const bf16_t* Qw = Q + (rowbase + qa) * 1024 + h * 128 + c * 64 + 8 * hh;
            bf16x8 qf[4];
#pragma unroll
            for (int ks = 0; ks < 4; ++ks) qf[ks] = *(const bf16x8*)(Qw + 16 * ks);
            const float slope2 = exp2f(-(float)(h + 1)) * 1.4426950408889634f;
            const bf16_t* Kg = Kp + rowbase * 1024 + h * 128 + sch * 8; const bf16_t* Vg = Vp + rowbase * 1024 + h * 128 + sch * 8;
            u32x4 ak0, ak1, av0, av1, bk0, bk1, bv0, bv1;
#define LOADT(S, t) do { const size_t r_ = (size_t)((t) * 64 + sr0) * 1024; S##k0 = *(const u32x4*)(Kg + r_); S##k1 = *(const u32x4*)(Kg + r_ + 32 * 1024); S##v0 = *(const u32x4*)(Vg + r_); S##v1 = *(const u32x4*)(Vg + r_ + 32 * 1024); } while (0)
            LOADT(a, NT - 1); LOADT(b, NT - 2);
            float Bi;
            { float qn = 0.f;
#pragma unroll
              for (int ks = 0; ks < 4; ++ks)
#pragma unroll
                  for (int e2 = 0; e2 < 8; ++e2) { const float v = __builtin_bit_cast(float, ((unsigned)(unsigned short)qf[ks][e2]) << 16); qn += v * v; }
              qn += __shfl_xor(qn, 32);
              Bi = sqrtf(qn) * Kb;
              float dcut = (2.f * Bi + 40.f) / slope2;
#pragma unroll
              for (int o = 1; o < 32; o <<= 1) dcut = fmaxf(dcut, __shfl_xor(dcut, o));
              if (lane == 0) dsh[wave] = dcut; }
            f32x16 O[4];
#pragma unroll
            for (int cb = 0; cb < 4; ++cb)
#pragma unroll
                for (int i = 0; i < 16; ++i) O[cb][i] = 0.f;
            float l = 0.f, Mref = 0.f; bool first = true;
#define STORET(S, bf) do { LAS unsigned char* kb_ = lds + (bf) * BUFB; *(LAS u32x4*)(kb_ + sr0 * KP + sch * 16) = S##k0; *(LAS u32x4*)(kb_ + (sr0 + 32) * KP + sch * 16) = S##k1; \
        *(LAS u32x4*)(kb_ + KBYTES + sr0 * VP + sch * 16) = S##v0; *(LAS u32x4*)(kb_ + KBYTES + (sr0 + 32) * VP + sch * 16) = S##v1; } while (0)
            STORET(a, 0); if (NT >= 3) LOADT(a, NT - 3);
            __syncthreads();
            int NTe = NT; bool fast = false;
            { float dm = dsh[0];
#pragma unroll
              for (int w2 = 1; w2 < 8; ++w2) dm = fmaxf(dm, dsh[w2]);
              const float lim = (float)(q0 - 63) - dm;
              if (lim >= 0.f) { const int tlo = (int)floorf(lim * (1.f / 64)) + 1; NTe = NT - tlo; if (NTe < 2) NTe = 2; }
              fast = (dm * slope2 - 40.f) * 0.5f < 55.f; }
            if (fast) Mref = Bi;
            const int qtop = q0 + 32 * j + 31;
#define ATT_LOOP(FF) do { \
            for (int it = 0; it < NTe; it += 2) { \
                const int t = NT - 1 - it; \
                if (64 * t <= qtop) { attn_tile(FF, lds, 64 * t, qa, hh, r32, c, vrow, vbyte, slope2, qf, O, l, Mref, first); } \
                if (it + 1 < NTe) STORET(b, 1); \
                if (it + 3 < NTe) LOADT(b, t - 3); \
                __syncthreads(); \
                if (it + 1 >= NTe) break; \
                if (64 * (t - 1) <= qtop) { attn_tile(FF, lds + BUFB, 64 * (t - 1), qa, hh, r32, c, vrow, vbyte, slope2, qf, O, l, Mref, first); } \
                if (it + 2 < NTe) STORET(a, 0); \
                if (it + 4 < NTe) LOADT(a, t - 4); \
                __syncthreads(); \
            } \
            } while (0)
            ATT_LOOP(fast);
#undef ATT_LOOP
#undef LOADT
#undef STORET
            const float lt = l + __shfl_xor(l, 32); const float inv = 1.f / lt;
            LAS float* ex = (LAS float*)(lds + EXCH + j * 16384);
            if (c == 1) {
#pragma unroll
                for (int cb = 0; cb < 4; ++cb)
#pragma unroll
                    for (int i = 0; i < 16; ++i) ex[(cb * 16 + i) * 64 + lane] = O[cb][i] * inv;
            }
            __syncthreads();
            if (c == 0) {
                float ss = 0.f;
#pragma unroll
                for (int cb = 0; cb < 4; ++cb)
#pragma unroll
                    for (int i = 0; i < 16; ++i) { const float d = O[cb][i] * inv - lam * ex[(cb * 16 + i) * 64 + lane]; O[cb][i] = d; ss += d * d; }
                ss += __shfl_xor(ss, 32);
                const float rs = 0.8f / sqrtf(ss * (1.f / 128) + EPS);
                const size_t orow = (size_t)(rowbase + qa) * 1024 + h * 128;
#pragma unroll
                for (int cb = 0; cb < 4; ++cb)
#pragma unroll
                    for (int g4 = 0; g4 < 4; ++g4) { const int dv = 32 * cb + 8 * g4 + 4 * hh;
                        const f32x4 gs = *(const f32x4*)(subln_g + dv); const u32x2 z = *(const u32x2*)(SZ + orow + dv);
                        u32x2 w; w.x = cvt_pk_bf16(O[cb][4 * g4] * rs * gs[0] * bflo(z.x), O[cb][4 * g4 + 1] * rs * gs[1] * bfhi(z.x));
                        w.y = cvt_pk_bf16(O[cb][4 * g4 + 2] * rs * gs[2] * bflo(z.y), O[cb][4 * g4 + 3] * rs * gs[3] * bfhi(z.y));
                        *(u32x2*)(AG + orow + dv) = w; }
            }
            if (tid == 0) *nxt_slot = nxt_reg;
        }
        __syncthreads();
        cur = *nxt_slot;
    }
}


__device__ __forceinline__ void late_weight_copies(const Args& a, LAS unsigned char* lds, int vcu, int G) {
    const int tid = threadIdx.x, lane = tid & 63, wave = tid >> 6;
    unsigned char* ws = a.ws;
    LAS float* scr = (LAS float*)(lds + wave * 16384);
    const int gw = vcu * 8 + wave, NGW = G * 8;
    constexpr int I_OA = 16 * 32, I_GL = 8 * 16, I_OS = 8 * 32, I_OUT = 16 * 32;
    for (int it = gw; it < I_OA + I_GL + I_OS + I_OUT; it += NGW) {
        int r = it;
        if (r < I_OA) { transpose_item(a.in[8], 1024, 1024, nullptr, (bf16_t*)(ws + WS_WOATT), scr, r, lane); continue; } r -= I_OA;
        if (r < I_GL) { transpose_item(a.in[17], 512, 512, nullptr, (bf16_t*)(ws + WS_WGLU), scr, r, lane); continue; } r -= I_GL;
        if (r < I_OS) { transpose_item(a.in[19], 512, 1024, nullptr, (bf16_t*)(ws + WS_WOSSM), scr, r, lane); continue; } r -= I_OS;
        transpose_item(a.in[20], 1024, 1024, nullptr, (bf16_t*)(ws + WS_WOUT), scr, r, lane);
    }
}
__global__ void __launch_bounds__(512, 2) fwd_mega(Args a) {
    extern __shared__ __attribute__((aligned(16))) unsigned char lds_raw[];
    LAS unsigned char* lds = (LAS unsigned char*)lds_raw;
    cg::grid_group grid = cg::this_grid();
    volatile LAS unsigned* MISC = (volatile LAS unsigned*)(lds + LDS_BYTES - 64);
    if (threadIdx.x < 16) MISC[threadIdx.x] = 0u;
    __syncthreads();
    XcdBarrier bar = xcd_barrier_post((unsigned*)(a.ws + WS_BAR), MISC);
    const int G = gridDim.x, bx = blockIdx.x;
    const int vcu = (G % 8 == 0) ? (bx % 8) * (G / 8) + bx / 8 : bx;
    const int lo = a.ph_lo, hi = a.ph_hi;
    unsigned char* ws = a.ws;
    bf16_t* proj = (bf16_t*)(ws + WS_PROJ);
    bf16_t* xb = (bf16_t*)a.out; bf16_t* ag = (bf16_t*)a.out + (size_t)T * 1024;
    bf16_t* ys = (bf16_t*)(ws + WS_YS);
#define IN(k) (lo <= (k) && (k) < hi)
#define SEAM(k) do { if (IN(k) && IN((k) + 1)) { if (lo < 0) grid.sync(); else xcd_barrier(bar); } } while (0)
    if (IN(0)) p0_prologue(a, lds, vcu, G);
    SEAM(0);
    if (IN(1)) {
        __syncthreads();
        pg8::Gemm g{xb, (const bf16_t*)(ws + WS_WIN), T, NIN, 1024}; pg8::StaticOrder S; S.init(T, NIN, G, bx, 3);
        EpiProj E{proj, (unsigned*)(ws + WS_KMAX)};
        pg8::gemm_phase<EpiProj, pg8::StaticOrder, true, true>(lds, g, S, E);
    }
    SEAM(1);
    if (IN(2)) {
        __syncthreads();
        ssm_phase(lds, proj + PU, (const float*)(ws + WS_LBAR), (const float*)(ws + WS_LB256), (const bf16_t*)(ws + WS_BB), (const bf16_t*)(ws + WS_CM), a.in[16], ys, bx, G);
        __syncthreads();
        const int lane = threadIdx.x & 63;
        const float s1 = wave_sum(a.in[3][lane] * a.in[4][lane]), s2 = wave_sum(a.in[5][lane] * a.in[6][lane]);
        const float lam = expf(s1) - expf(s2) + 0.2f;
        attn_phase(lds, proj + PQ, proj + PK, proj + PV, proj + PSZA, ag, a.in[7], lam, (unsigned*)(ws + WS_QCTR), (const unsigned*)(ws + WS_KMAX));
        __syncthreads();
        late_weight_copies(a, lds, vcu, G);
    }
    SEAM(2);
    if (IN(3)) {
        __syncthreads();
        pg8::Gemm g{ys, (const bf16_t*)(ws + WS_WGLU), T, 512, 512}; pg8::StaticOrder S; S.init(T, 512, G, bx);
        EpiGlu E{ys, proj + PSZS, a.in[18], proj + PS};
        pg8::gemm_phase<EpiGlu, pg8::StaticOrder, true, true>(lds, g, S, E);
    }
    SEAM(3);
    if (IN(4)) {
        __syncthreads();
        { pg8::Gemm g{ag, (const bf16_t*)(ws + WS_WOATT), T, 1024, 1024}; pg8::StaticOrder S; S.init(T, 1024, G, bx);
          EpiGate<0> E{proj + PGA, nullptr, proj + PY1};
          pg8::gemm_phase<EpiGate<0>, pg8::StaticOrder, true, true>(lds, g, S, E); }
        __syncthreads();
        { pg8::Gemm g{proj + PS, (const bf16_t*)(ws + WS_WOSSM), T, 1024, 512}; pg8::StaticOrder S; S.init(T, 1024, G, bx);
          EpiGate<1> E{proj + PGS, proj + PY1, proj + PMG};
          pg8::gemm_phase<EpiGate<1>, pg8::StaticOrder, true, true>(lds, g, S, E); }
    }
    SEAM(4);
    if (IN(5)) {
        __syncthreads();
        pg8::Gemm g{proj + PMG, (const bf16_t*)(ws + WS_WOUT), T, 1024, 1024}; pg8::StaticOrder S; S.init(T, 1024, G, bx);
        EpiOutNorm E{a.in[0], a.out, (float*)(ws + WS_ROWSQ), (unsigned*)(ws + WS_CNT), a.in[21]};
        pg8::gemm_phase<EpiOutNorm, pg8::StaticOrder, true, true>(lds, g, S, E);
    }
#undef IN
#undef SEAM
}

extern "C" void kernel_launch(void* const* d_in, const int* in_sizes, int n_in, void* d_out, int out_size, void* d_ws, size_t ws_size, hipStream_t stream) {
    static int grid = 0;
    if (grid == 0) {
        if (n_in != 22 || out_size != T * 1024 || ws_size < WS_END) { fprintf(stderr, "kernel_launch: unexpected shapes (n_in %d out %d ws %zu)\n", n_in, out_size, ws_size); grid = -1; return; }
        int dev = 0, cus = 0, per_cu = 0;
        (void)hipGetDevice(&dev); (void)hipDeviceGetAttribute(&cus, hipDeviceAttributeMultiprocessorCount, dev);
        if (hipFuncSetAttribute((const void*)fwd_mega, hipFuncAttributeMaxDynamicSharedMemorySize, LDS_BYTES) != hipSuccess) { fprintf(stderr, "kernel_launch: hipFuncSetAttribute failed\n"); grid = -1; return; }
        if (hipOccupancyMaxActiveBlocksPerMultiprocessor(&per_cu, (const void*)fwd_mega, 512, LDS_BYTES) != hipSuccess || per_cu < 1) { fprintf(stderr, "kernel_launch: occupancy query failed (%d)\n", per_cu); grid = -1; return; }
        grid = cus * per_cu;
    }
    if (grid < 0) return;
    if (hipMemsetAsync((char*)d_ws + WS_BAR, 0, 32768, stream) != hipSuccess) { fprintf(stderr, "kernel_launch: memset failed\n"); return; }
    Args a{};
    for (int i = 0; i < 22; ++i) a.in[i] = (const float*)d_in[i];
    a.out = (float*)d_out; a.ws = (unsigned char*)d_ws; a.ph_lo = 0; a.ph_hi = 6;
    void* args[] = {&a};
    hipError_t e = hipLaunchCooperativeKernel((const void*)fwd_mega, dim3(grid), dim3(512), args, LDS_BYTES, stream);
    if (e != hipSuccess) fprintf(stderr, "kernel_launch: cooperative launch failed: %s (grid %d)\n", hipGetErrorString(e), grid);
}
```

```cpp
#include <hip/hip_runtime.h>
#include <hip/hip_cooperative_groups.h>
#include <cstdio>
#include <cstdint>
namespace cg = cooperative_groups;
namespace pg8 {
#define PG8_LAS __attribute__((address_space(3)))
typedef unsigned short bf16_t;
typedef short bf16x8 __attribute__((ext_vector_type(8)));
typedef float f32x4 __attribute__((ext_vector_type(4)));
typedef unsigned u32x4 __attribute__((ext_vector_type(4)));
constexpr int BM = 256, BK = 64, HALF = 128, HTB = HALF * BK * 2  , STAGE_BYTES = 8 * HTB, NXCD = 8, WGM = 8;

__host__ __device__ __forceinline__ int lds_byte(int r, int c) { const int st = (r >> 4) * 2 + (c >> 5), rr = r & 15, cc = c & 31, ob = rr * 64 + cc * 2; return st * 1024 + (ob ^ (((ob >> 9) & 1) << 5)); }
__host__ __device__ __forceinline__ void stage_rc(int b, int& R, int& C) { const int st = b / 1024, sb = b % 1024, swz = sb ^ (((sb >> 9) & 1) << 5); R = (st >> 1) * 16 + swz / 64; C = (st & 1) * 32 + (swz % 64) / 2; }
__host__ __device__ __forceinline__ int perm32(int rho) { const int n = rho >> 4, i = rho & 15; return 8 * (i >> 2) + 4 * n + (i & 3); }

struct Unit { int pm, pn; };
struct Gemm { const bf16_t* A; const bf16_t* Bt; int M, N, K; };
struct StaticOrder {
    int nM, nN, nwg, G, c, wgm;
    __host__ __device__ void init(int M, int N, int G_, int c_, int wgm_ = WGM) { nM = M / BM; nN = N / BM; nwg = nM * nN; G = G_; c = c_; wgm = wgm_; }
    __host__ __device__ bool next(int i, Unit& u) const {
        const long L = (long)i * G + c; if (L >= nwg) return false;
        int wgid = (int)L; { const int q = nwg / NXCD, r = nwg % NXCD, xcd = wgid % NXCD, off = wgid / NXCD; wgid = (xcd < r ? xcd * (q + 1) : r * (q + 1) + (xcd - r) * q) + off; }
        const int nig = wgm * nN, gid = wgid / nig, fm = gid * wgm, gsz = (nM - fm) < wgm ? (nM - fm) : wgm;
        u.pm = fm + ((wgid % nig) % gsz); u.pn = (wgid % nig) / gsz; return true;
    }
    __device__ __forceinline__ void a_ready(const Unit&) const {}
    __device__ __forceinline__ void done(const Unit&) const {}
};
__device__ __forceinline__ unsigned cvt_pk_bf16(float lo, float hi) { unsigned r; asm volatile("v_cvt_pk_bf16_f32 %0, %1, %2" : "=v"(r) : "v"(lo), "v"(hi)); return r; }
typedef float f32x2 __attribute__((ext_vector_type(2)));
template <class Epi, class Sched, bool ALIGN_EPI = false, bool SP2 = false>
__device__ __forceinline__ void gemm_phase(PG8_LAS unsigned char* lds, const Gemm g, const Sched& S, const Epi& E) {
    const int tid = threadIdx.x, wid = __builtin_amdgcn_readfirstlane(tid >> 6), lane = tid & 63, wr = wid >> 2, wc = wid & 3, fr = lane & 15, fq = lane >> 4;
    const int K = g.K, nt = K / BK;
    unsigned voffA[2], voffB[2];
#pragma unroll
    for (int i = 0; i < 2; ++i) { int R, C; stage_rc(tid * 16 + i * 8192, R, C); const int Rb = Epi::PERM ? ((R & ~31) + perm32(R & 31)) : R;
        voffA[i] = (unsigned)(R * K + C) * 2u; voffB[i] = (unsigned)(Rb * K + C) * 2u; }
    const size_t kstep = (size_t)(BK * 2);
    const size_t hstep = (size_t)HALF * K * 2;
    const size_t tstep = 2 * hstep;
    const unsigned ldsw = (unsigned)wid * 1024u;
    const int aoff = lds_byte(wr * 64 + fr, fq * 8), boff = lds_byte(wc * 32 + fr, fq * 8);
#define PG8_SA(b, h) (((b) * 2 + (h)) * HTB)
#define PG8_SB(b, h) ((4 + (b) * 2 + (h)) * HTB)
#define PG8_STAGE(bufoff, gbase, voff) do { _Pragma("unroll") for (int _i = 0; _i < 2; ++_i) \
        __builtin_amdgcn_global_load_lds((const unsigned*)((const char*)(gbase) + (voff)[_i]), (PG8_LAS unsigned*)(lds + (bufoff) + ldsw + _i * 8192), 16, 0, 0); } while (0)
#define PG8_LDA(dst, b, h) do { _Pragma("unroll") for (int m = 0; m < 4; ++m) _Pragma("unroll") for (int k = 0; k < 2; ++k) dst[m][k] = *(const PG8_LAS bf16x8*)(lds + PG8_SA(b, h) + aoff + m * 2048 + k * 1024); } while (0)
#define PG8_LDB(dst, b, h) do { _Pragma("unroll") for (int n = 0; n < 2; ++n) _Pragma("unroll") for (int k = 0; k < 2; ++k) dst[n][k] = *(const PG8_LAS bf16x8*)(lds + PG8_SB(b, h) + boff + n * 2048 + k * 1024); } while (0)
#define PG8_MMA(ai, bj, At, Bt) do { __builtin_amdgcn_s_setprio(1); _Pragma("unroll") for (int m = 0; m < 4; ++m) _Pragma("unroll") for (int n = 0; n < 2; ++n) _Pragma("unroll") for (int k = 0; k < 2; ++k) \
        acc[ai][bj][m][n] = __builtin_amdgcn_mfma_f32_16x16x32_bf16(Bt[n][k], At[m][k], acc[ai][bj][m][n], 0, 0, 0); __builtin_amdgcn_s_setprio(0); } while (0)
#define PG8_WAIT_V(n) asm volatile("s_waitcnt vmcnt(" #n ")" ::: "memory")
#define PG8_WAIT_L(n) asm volatile("s_waitcnt lgkmcnt(" #n ")" ::: "memory")
#define PG8_BAR __builtin_amdgcn_s_barrier()
#define PG8_SCHED __builtin_amdgcn_sched_barrier(0)
    Unit cur, nxt; int ui = 0;
    if (!S.next(0, cur)) return;
    f32x4 acc[2][2][4][2];
#pragma unroll
    for (int a = 0; a < 2; ++a)
#pragma unroll
        for (int b = 0; b < 2; ++b)
#pragma unroll
            for (int m = 0; m < 4; ++m)
#pragma unroll
                for (int n = 0; n < 2; ++n) acc[a][b][m][n] = (f32x4){0.f, 0.f, 0.f, 0.f};
    bf16x8 At[4][2], B0[2][2], B1[2][2];
    const char* cA = (const char*)g.A + (size_t)cur.pm * tstep; const char* cB = (const char*)g.Bt + (size_t)cur.pn * tstep;
    S.a_ready(cur);
    if constexpr (SP2) {
        PG8_STAGE(PG8_SB(0, 0), cB, voffB); PG8_STAGE(PG8_SB(0, 1), cB + hstep, voffB); PG8_STAGE(PG8_SA(0, 0), cA, voffA); PG8_STAGE(PG8_SA(0, 1), cA + hstep, voffA);
        if (wr == 1) PG8_BAR;
        PG8_WAIT_V(2); PG8_BAR;
        PG8_STAGE(PG8_SB(1, 0), cB + kstep, voffB); PG8_STAGE(PG8_SA(1, 0), cA + kstep, voffA); PG8_STAGE(PG8_SB(1, 1), cB + hstep + kstep, voffB);
        PG8_WAIT_V(6); PG8_BAR;
    } else {
        PG8_STAGE(PG8_SB(0, 0), cB, voffB); PG8_STAGE(PG8_SA(0, 0), cA, voffA); PG8_STAGE(PG8_SB(0, 1), cB + hstep, voffB); PG8_STAGE(PG8_SA(0, 1), cA + hstep, voffA);
        if (wr == 1) PG8_BAR;
        PG8_WAIT_V(4); PG8_BAR;
        PG8_STAGE(PG8_SB(1, 0), cB + kstep, voffB); PG8_STAGE(PG8_SA(1, 0), cA + kstep, voffA); PG8_STAGE(PG8_SB(1, 1), cB + hstep + kstep, voffB);
        PG8_WAIT_V(6); PG8_BAR;
    }
    for (;;) {
        const bool has_next = S.next(ui + 1, nxt);
        const char* nA = has_next ? (const char*)g.A + (size_t)nxt.pm * tstep : cA; const char* nB = has_next ? (const char*)g.Bt + (size_t)nxt.pn * tstep : cB;
        for (int t = 0; t < nt; t += 2) {
            const bool last = (t == nt - 2);
            const char* a1 = cA + (size_t)(t + 1) * kstep;
            const char* a2 = last ? nA : cA + (size_t)(t + 2) * kstep; const char* b2 = last ? nB : cB + (size_t)(t + 2) * kstep;
            const char* a3 = a2 + kstep; const char* b3 = b2 + kstep;
            if (last && has_next) S.a_ready(nxt);
            if constexpr (SP2) {
            PG8_LDB(B0, 0, 0); PG8_LDB(B1, 0, 1); PG8_SCHED; PG8_LDA(At, 0, 0); PG8_STAGE(PG8_SA(1, 1), a1 + hstep, voffA);
            PG8_WAIT_V(8); PG8_WAIT_L(0); PG8_BAR; PG8_MMA(0, 0, At, B0); PG8_MMA(0, 1, At, B1); PG8_BAR; PG8_SCHED;
            PG8_LDA(At, 0, 1); PG8_STAGE(PG8_SB(0, 0), b2, voffB); PG8_STAGE(PG8_SB(0, 1), b2 + hstep, voffB); PG8_STAGE(PG8_SA(0, 0), a2, voffA);
            PG8_WAIT_V(8); PG8_WAIT_L(0); PG8_BAR; PG8_MMA(1, 0, At, B0); PG8_MMA(1, 1, At, B1); PG8_BAR; PG8_SCHED;
            PG8_LDB(B0, 1, 0); PG8_LDB(B1, 1, 1); PG8_SCHED; PG8_LDA(At, 1, 0); PG8_STAGE(PG8_SA(0, 1), a2 + hstep, voffA);
            PG8_WAIT_V(8); PG8_WAIT_L(0); PG8_BAR; PG8_MMA(0, 0, At, B0); PG8_MMA(0, 1, At, B1); PG8_BAR; PG8_SCHED;
            PG8_LDA(At, 1, 1); PG8_STAGE(PG8_SB(1, 0), b3, voffB); PG8_STAGE(PG8_SB(1, 1), b3 + hstep, voffB); PG8_STAGE(PG8_SA(1, 0), a3, voffA);
            PG8_WAIT_V(8); PG8_WAIT_L(0); PG8_BAR; PG8_MMA(1, 0, At, B0); PG8_MMA(1, 1, At, B1); PG8_BAR; PG8_SCHED;
            } else {
            PG8_LDB(B0, 0, 0); PG8_SCHED; PG8_LDA(At, 0, 0); PG8_STAGE(PG8_SA(1, 1), a1 + hstep, voffA);
            PG8_WAIT_L(8); PG8_BAR; PG8_WAIT_L(0); PG8_MMA(0, 0, At, B0); PG8_BAR; PG8_SCHED;
            PG8_LDB(B1, 0, 1); PG8_STAGE(PG8_SB(0, 0), b2, voffB);
            PG8_BAR; PG8_WAIT_L(0); PG8_MMA(0, 1, At, B1); PG8_BAR;
            PG8_LDA(At, 0, 1); PG8_STAGE(PG8_SA(0, 0), a2, voffA);
            PG8_BAR; PG8_WAIT_L(0); PG8_MMA(1, 0, At, B0); PG8_BAR; PG8_SCHED;
            PG8_STAGE(PG8_SB(0, 1), b2 + hstep, voffB);
            PG8_WAIT_V(6); PG8_BAR; PG8_MMA(1, 1, At, B1); PG8_BAR;
            PG8_LDB(B0, 1, 0); PG8_SCHED; PG8_LDA(At, 1, 0); PG8_STAGE(PG8_SA(0, 1), a2 + hstep, voffA);
            PG8_WAIT_L(8); PG8_BAR; PG8_WAIT_L(0); PG8_MMA(0, 0, At, B0); PG8_BAR; PG8_SCHED;
            PG8_LDB(B1, 1, 1); PG8_STAGE(PG8_SB(1, 0), b3, voffB);
            PG8_BAR; PG8_WAIT_L(0); PG8_MMA(0, 1, At, B1); PG8_BAR;
            PG8_LDA(At, 1, 1); PG8_STAGE(PG8_SA(1, 0), a3, voffA);
            PG8_BAR; PG8_WAIT_L(0); PG8_MMA(1, 0, At, B0); PG8_BAR; PG8_SCHED;
            PG8_STAGE(PG8_SB(1, 1), b3 + hstep, voffB);
            PG8_WAIT_V(6); PG8_BAR; PG8_MMA(1, 1, At, B1); PG8_BAR;
            }
        }
        if constexpr (ALIGN_EPI) { if (wr == 0) PG8_BAR; }
        if constexpr (!Epi::AFTER_DRAIN) { E(acc, cur, wr, wc, fr, fq); S.done(cur); }
        if (!has_next) break;
#pragma unroll
        for (int a = 0; a < 2; ++a)
#pragma unroll
            for (int b = 0; b < 2; ++b)
#pragma unroll
                for (int m = 0; m < 4; ++m)
#pragma unroll
                    for (int n = 0; n < 2; ++n) acc[a][b][m][n] = (f32x4){0.f, 0.f, 0.f, 0.f};
        cur = nxt; cA = nA; cB = nB; ++ui;
        if constexpr (ALIGN_EPI) { if (wr == 1) PG8_BAR; }
    }
    PG8_WAIT_V(0);
    if constexpr (!ALIGN_EPI) { if (wr == 0) PG8_BAR; }
    PG8_BAR;
    if constexpr (Epi::AFTER_DRAIN) { E.fused(acc, cur, wr, wc, fr, fq, lds, wid, lane); S.done(cur); }
#undef PG8_SA
#undef PG8_SB
#undef PG8_STAGE
#undef PG8_LDA
#undef PG8_LDB
#undef PG8_MMA
#undef PG8_WAIT_V
#undef PG8_WAIT_L
#undef PG8_BAR
#undef PG8_SCHED
}
}

using pg8::bf16_t; using pg8::bf16x8; using pg8::f32x4; using pg8::u32x4; using pg8::Unit; using pg8::cvt_pk_bf16;
#define LAS __attribute__((address_space(3)))
typedef float f32x16 __attribute__((ext_vector_type(16)));
typedef float f32x2v __attribute__((ext_vector_type(2)));
typedef short s16x4 __attribute__((ext_vector_type(4)));
typedef unsigned u32x2 __attribute__((ext_vector_type(2)));
#define MFMA32(a, b, c) __builtin_amdgcn_mfma_f32_32x32x16_bf16((a), (b), (c), 0, 0, 0)

constexpr int T = 32768, SEQ = 2048, DM = 1024, NIN = 7168, SW = 512;
constexpr size_t MiB = 1u << 20;
constexpr size_t WS_ROWSQ = 0;
constexpr size_t WS_BAR = 512 * 1024;
constexpr size_t WS_QCTR = WS_BAR + 24576, WS_KMAX = WS_BAR + 24576 + 64;
constexpr size_t WS_CNT = WS_BAR + 16384;
constexpr size_t WS_WIN = 2 * MiB, WS_WOATT = 16 * MiB, WS_WGLU = 18 * MiB, WS_WOSSM = 19 * MiB, WS_WOUT = 20 * MiB;
constexpr size_t WS_LBAR = 22 * MiB, WS_LB256 = 22 * MiB + 32 * 1024, WS_BB = 22 * MiB + 64 * 1024, WS_CM = 22 * MiB + 256 * 1024;
constexpr size_t WS_YS = 24 * MiB;
constexpr size_t WS_PROJ = 64 * MiB;
constexpr size_t WS_END = 512 * MiB;
constexpr size_t PQ = 0, PK = (size_t)T * 1024, PV = 2 * (size_t)T * 1024, PSZA = 3 * (size_t)T * 1024, PU = 4 * (size_t)T * 1024,
                 PSZS = PU + (size_t)T * 512, PGA = 5 * (size_t)T * 1024, PGS = 6 * (size_t)T * 1024;
constexpr size_t PS = PQ, PY1 = PK, PMG = PV;
constexpr int LDS_BYTES = 147456;
constexpr float C2 = 0.125f * 1.4426950408889634f;
constexpr float EPS = 1e-5f;

__device__ __forceinline__ unsigned f2bf(float f) { unsigned u = __builtin_bit_cast(unsigned, f); return (u + 0x7fffu + ((u >> 16) & 1u)) >> 16; }
__device__ __forceinline__ unsigned pk2(float lo, float hi) { return f2bf(lo) | (f2bf(hi) << 16); }
__device__ __forceinline__ float bflo(unsigned w) { return __builtin_bit_cast(float, w << 16); }
__device__ __forceinline__ float bfhi(unsigned w) { return __builtin_bit_cast(float, w & 0xffff0000u); }
__device__ __forceinline__ float sigm(float x) { return __builtin_amdgcn_rcpf(1.f + __expf(-x)); }
__device__ __forceinline__ float wave_sum(float v) {
#pragma unroll
    for (int o = 1; o < 64; o <<= 1) v += __shfl_xor(v, o);
    return v;
}
__device__ __forceinline__ u32x4 pack8(const f32x4& a, const f32x4& b) { u32x4 w; w.x = cvt_pk_bf16(a[0], a[1]); w.y = cvt_pk_bf16(a[2], a[3]); w.z = cvt_pk_bf16(b[0], b[1]); w.w = cvt_pk_bf16(b[2], b[3]); return w; }
__device__ __forceinline__ void unpack8(const u32x4& w, f32x4& a, f32x4& b) { a = (f32x4){bflo(w.x), bfhi(w.x), bflo(w.y), bfhi(w.y)}; b = (f32x4){bflo(w.z), bfhi(w.z), bflo(w.w), bfhi(w.w)}; }

struct EpiProj {
    static constexpr bool PERM = true, AFTER_DRAIN = false;
    bf16_t* proj; unsigned* kmax;
    __device__ __forceinline__ void operator()(const f32x4 (&acc)[2][2][4][2], const Unit& u, int wr, int wc, int fr, int fq) const {
        const int colt = u.pn * 256; int start, pitch, act; size_t off;
        if (colt < 1024) { start = 0; pitch = 1024; off = PQ; act = 3; }
        else if (colt < 2048) { start = 1024; pitch = 1024; off = PK; act = 4; }
        else if (colt < 3072) { start = 2048; pitch = 1024; off = PV; act = 0; }
        else if (colt < 4096) { start = 3072; pitch = 1024; off = PSZA; act = 1; }
        else if (colt < 4608) { start = 4096; pitch = 512; off = PU; act = 0; }
        else if (colt < 5120) { start = 4608; pitch = 512; off = PSZS; act = 1; }
        else if (colt < 6144) { start = 5120; pitch = 1024; off = PGA; act = 2; }
        else { start = 6144; pitch = 1024; off = PGS; act = 2; }
        const int row0 = u.pm * 256 + wr * 64 + fr, col0 = colt - start + wc * 32 + 8 * fq;
        bf16_t* base = proj + off; float kn = 0.f;
#pragma unroll
        for (int ai = 0; ai < 2; ++ai)
#pragma unroll
            for (int m = 0; m < 4; ++m) { bf16_t* rowp = base + (size_t)(row0 + ai * 128 + m * 16) * pitch + col0;
#pragma unroll
                for (int bj = 0; bj < 2; ++bj) { f32x4 v0 = acc[ai][bj][m][0], v1 = acc[ai][bj][m][1];
                    if (act == 1) {
#pragma unroll
                        for (int e = 0; e < 4; ++e) { v0[e] = v0[e] * sigm(v0[e]); v1[e] = v1[e] * sigm(v1[e]); } }
                    else if (act == 2) {
#pragma unroll
                        for (int e = 0; e < 4; ++e) { v0[e] = sigm(v0[e]); v1[e] = sigm(v1[e]); } }
                    else if (act == 3) { v0 = v0 * C2; v1 = v1 * C2; }
                    else if (act == 4) { float ss = (v0[0] * v0[0] + v0[1] * v0[1]) + (v0[2] * v0[2] + v0[3] * v0[3]) + (v1[0] * v1[0] + v1[1] * v1[1]) + (v1[2] * v1[2] + v1[3] * v1[3]);
                        ss += __shfl_xor(ss, 16); ss += __shfl_xor(ss, 32); kn = fmaxf(kn, ss); }
                    *(u32x4*)(rowp + bj * 128) = pack8(v0, v1); } }
        if (act == 4) {
#pragma unroll
            for (int o = 1; o < 16; o <<= 1) kn = fmaxf(kn, __shfl_xor(kn, o));
            if ((threadIdx.x & 63) == 0) atomicMax(kmax, __builtin_bit_cast(unsigned, kn));
        }
    }
};
struct EpiGlu {
    static constexpr bool PERM = true, AFTER_DRAIN = false;
    const bf16_t* ys; const bf16_t* szs; const float* bglu; bf16_t* S;
    __device__ __forceinline__ void operator()(const f32x4 (&acc)[2][2][4][2], const Unit& u, int wr, int wc, int fr, int fq) const {
        const int row0 = u.pm * 256 + wr * 64 + fr, col0 = u.pn * 256 + wc * 32 + 8 * fq;
#pragma unroll
        for (int ai = 0; ai < 2; ++ai)
#pragma unroll
            for (int m = 0; m < 4; ++m) { const size_t ro = (size_t)(row0 + ai * 128 + m * 16) * 512 + col0;
#pragma unroll
                for (int bj = 0; bj < 2; ++bj) { const size_t o = ro + bj * 128;
                    const f32x4 b0 = *(const f32x4*)(bglu + col0 + bj * 128), b1 = *(const f32x4*)(bglu + col0 + bj * 128 + 4);
                    f32x4 y0, y1, z0, z1; unpack8(*(const u32x4*)(ys + o), y0, y1); unpack8(*(const u32x4*)(szs + o), z0, z1);
                    f32x4 v0 = acc[ai][bj][m][0] + b0, v1 = acc[ai][bj][m][1] + b1;
#pragma unroll
                    for (int e = 0; e < 4; ++e) { v0[e] = y0[e] * sigm(v0[e]) * z0[e]; v1[e] = y1[e] * sigm(v1[e]) * z1[e]; }
                    *(u32x4*)(S + o) = pack8(v0, v1); } }
    }
};
template <int MODE> struct EpiGate {
    static constexpr bool PERM = true, AFTER_DRAIN = false;
    const bf16_t* gate; const bf16_t* y1; bf16_t* O;
    __device__ __forceinline__ void operator()(const f32x4 (&acc)[2][2][4][2], const Unit& u, int wr, int wc, int fr, int fq) const {
        const int row0 = u.pm * 256 + wr * 64 + fr, col0 = u.pn * 256 + wc * 32 + 8 * fq;
#pragma unroll
        for (int ai = 0; ai < 2; ++ai)
#pragma unroll
            for (int m = 0; m < 4; ++m) { const size_t ro = (size_t)(row0 + ai * 128 + m * 16) * 1024 + col0;
#pragma unroll
                for (int bj = 0; bj < 2; ++bj) { const size_t o = ro + bj * 128;
                    f32x4 g0, g1; unpack8(*(const u32x4*)(gate + o), g0, g1);
                    f32x4 v0 = acc[ai][bj][m][0] * g0, v1 = acc[ai][bj][m][1] * g1;
                    if (MODE == 1) { f32x4 p0, p1; unpack8(*(const u32x4*)(y1 + o), p0, p1); v0 += p0; v1 += p1; }
                    *(u32x4*)(O + o) = pack8(v0, v1); } }
    }
};
struct EpiOutNorm {
    static constexpr bool PERM = true, AFTER_DRAIN = false;
    const float* x; float* out; float* rowsq; unsigned* cnt; const float* fg;
    __device__ __forceinline__ void operator()(const f32x4 (&acc_c)[2][2][4][2], const Unit& u, int wr, int wc, int fr, int fq) const {
        f32x4 (&acc)[2][2][4][2] = const_cast<f32x4 (&)[2][2][4][2]>(acc_c);
        const int row0 = u.pm * 256 + wr * 64 + fr, col0 = u.pn * 256 + wc * 32 + 8 * fq;
        float olds[8];
#pragma unroll
        for (int e = 0; e < 8; ++e) olds[e] = 0.f;
#pragma unroll
        for (int ai = 0; ai < 2; ++ai)
#pragma unroll
            for (int m = 0; m < 4; ++m) { const int row = row0 + ai * 128 + m * 16; const size_t ro = (size_t)row * 1024 + col0; float ss = 0.f;
#pragma unroll
                for (int bj = 0; bj < 2; ++bj) { const size_t o = ro + bj * 128;
                    const f32x4 r0 = *(const f32x4*)(x + o) + acc[ai][bj][m][0], r1 = *(const f32x4*)(x + o + 4) + acc[ai][bj][m][1];
                    acc[ai][bj][m][0] = r0; acc[ai][bj][m][1] = r1;
                    ss += (r0[0] * r0[0] + r0[1] * r0[1]) + (r0[2] * r0[2] + r0[3] * r0[3]) + (r1[0] * r1[0] + r1[1] * r1[1]) + (r1[2] * r1[2] + r1[3] * r1[3]); }
                ss += __shfl_xor(ss, 16); ss += __shfl_xor(ss, 32);
                if (fq == 0) olds[ai * 4 + m] = unsafeAtomicAdd(rowsq + row, ss); }
        asm volatile("s_waitcnt vmcnt(0)" :: "v"(olds[0]), "v"(olds[1]), "v"(olds[2]), "v"(olds[3]), "v"(olds[4]), "v"(olds[5]), "v"(olds[6]), "v"(olds[7]) : "memory");
        unsigned* c = cnt + u.pm * 16;
        if ((threadIdx.x & 63) == 0) __hip_atomic_fetch_add(c, 1u, __ATOMIC_RELAXED, __HIP_MEMORY_SCOPE_AGENT);
        { unsigned sp = 0; while (__hip_atomic_load(c, __ATOMIC_RELAXED, __HIP_MEMORY_SCOPE_AGENT) < 32u) { __builtin_amdgcn_s_sleep(4); if (++sp > (1u << 22)) break; } }
        asm volatile("s_waitcnt vmcnt(0)" ::: "memory");
        f32x4 g[2][2];
#pragma unroll
        for (int bj = 0; bj < 2; ++bj) { g[bj][0] = *(const f32x4*)(fg + col0 + bj * 128); g[bj][1] = *(const f32x4*)(fg + col0 + bj * 128 + 4); }
#pragma unroll
        for (int ai = 0; ai < 2; ++ai)
#pragma unroll
            for (int m = 0; m < 4; ++m) { const int row = row0 + ai * 128 + m * 16; const size_t ro = (size_t)row * 1024 + col0;
                const float rs = 1.f / sqrtf(__hip_atomic_load(rowsq + row, __ATOMIC_RELAXED, __HIP_MEMORY_SCOPE_AGENT) * (1.f / 1024) + EPS);
#pragma unroll
                for (int bj = 0; bj < 2; ++bj) { const size_t o = ro + bj * 128;
                    *(f32x4*)(out + o) = acc[ai][bj][m][0] * rs * g[bj][0]; *(f32x4*)(out + o + 4) = acc[ai][bj][m][1] * rs * g[bj][1]; } }
    }
};

__device__ __forceinline__ void transpose_item(const float* W, int K, int N, const float* gk, bf16_t* WT, LAS float* scr, int item, int lane) {
    const int nblk = N / 32, kb = item / nblk, nb = item % nblk, k0 = 64 * kb, n0 = 32 * nb;
#pragma unroll 8
    for (int i = 0; i < 32; ++i) { const int kk = 2 * i + (lane >> 5); float v = __builtin_nontemporal_load(W + (size_t)(k0 + kk) * N + n0 + (lane & 31)); if (gk) v *= gk[k0 + kk]; scr[kk * 33 + (lane & 31)] = v; }
    asm volatile("s_waitcnt lgkmcnt(0)" ::: "memory");
    const int c = lane & 7;
#pragma unroll
    for (int j = 0; j < 4; ++j) { const int n = (lane >> 3) + 8 * j; const LAS float* s = scr + (8 * c) * 33 + n;
        u32x4 o; o.x = pk2(s[0 * 33], s[1 * 33]); o.y = pk2(s[2 * 33], s[3 * 33]); o.z = pk2(s[4 * 33], s[5 * 33]); o.w = pk2(s[6 * 33], s[7 * 33]);
        *(u32x4*)(WT + (size_t)(n0 + n) * K + k0 + 8 * c) = o; }
    asm volatile("s_waitcnt lgkmcnt(0)" ::: "memory");
}
__device__ __forceinline__ void sincos_small(double r, double& s, double& c) {
    const double r2 = r * r;
    s = r * (1.0 + r2 * (-1.0 / 6 + r2 * (1.0 / 120 + r2 * (-1.0 / 5040 + r2 * (1.0 / 362880 + r2 * (-1.0 / 39916800 + r2 * (1.0 / 6227020800.0)))))));
    c = 1.0 + r2 * (-0.5 + r2 * (1.0 / 24 + r2 * (-1.0 / 720 + r2 * (1.0 / 40320 + r2 * (-1.0 / 3628800 + r2 * (1.0 / 479001600.0 + r2 * (-1.0 / 87178291200.0)))))));
}
__device__ __forceinline__ void sincos_d(double th, double& s, double& c) {
    const double PI2 = 1.5707963267948966192313216916398;
    const double k = rint(th / PI2); const double r = th - k * PI2;
    double sr, cr; sincos_small(r, sr, cr);
    const int q = ((int)k) & 3;
    if (q == 0) { s = sr; c = cr; } else if (q == 1) { s = cr; c = -sr; } else if (q == 2) { s = -sr; c = -cr; } else { s = -cr; c = sr; }
}
__device__ __forceinline__ double exp_d(double x) {
    const double y = x * (1.0 / 256);
    double e = 1.0 + y * (1.0 + y * (0.5 + y * (1.0 / 6 + y * (1.0 / 24 + y * (1.0 / 120 + y * (1.0 / 720 + y * (1.0 / 5040 + y * (1.0 / 40320 + y * (1.0 / 362880 + y * (1.0 / 3628800))))))))));
    e *= e; e *= e; e *= e; e *= e; e *= e; e *= e; e *= e; e *= e; return e;
}
#define XB_TMO      128
#define XB_XCNT(j)  (256  + 64 * (j))
#define XB_XSUB(j)  (1280 + 64 * (j))
#define XB_XGEN(j)  (2304 + 64 * (j))
#define XB_TOP      3328
#define XB_TOPGEN   3392
#define XCD_BAR_WORDS 3456
#define XB_SPIN_CAP (1u << 18)

__device__ __forceinline__ unsigned xb_ld(unsigned* p)              { return __hip_atomic_load(p, __ATOMIC_RELAXED, __HIP_MEMORY_SCOPE_AGENT); }
__device__ __forceinline__ unsigned xb_add(unsigned* p, unsigned v) { return __hip_atomic_fetch_add(p, v, __ATOMIC_RELAXED, __HIP_MEMORY_SCOPE_AGENT); }
__device__ __forceinline__ unsigned xb_xcc_id() { return (unsigned)__builtin_amdgcn_s_getreg((3 << 11) | 20) & 0xFu; }
#define XB_SPIN(cond, bar) do { unsigned _sp = 0; while (cond) { __builtin_amdgcn_s_sleep(1); \
    if ((++_sp & 255u) == 0u) { if (xb_ld(&(bar)[XB_TMO])) break; if (_sp > XB_SPIN_CAP) { atomicAdd(&(bar)[XB_TMO], 1u); break; } } } } while (0)

struct XcdBarrier {
    unsigned* bar; unsigned x;
    volatile LAS unsigned* st;
};

__device__ __forceinline__ XcdBarrier xcd_barrier_post(unsigned* bar, volatile LAS unsigned* st) {
    XcdBarrier b; b.bar = bar; b.x = xb_xcc_id(); b.st = st;
    if (threadIdx.x == 0) (void)xb_add(&bar[XB_XCNT(b.x)], 1u);
    return b;
}
__device__ __forceinline__ void xcd_barrier_complete(unsigned* bar, unsigned x, unsigned& nloc, unsigned& nx) {
    const unsigned G = gridDim.x * gridDim.y * gridDim.z;
    unsigned sum, cnt, mine, sp = 0u;
    for (;;) {
        sum = 0u; cnt = 0u; mine = 0u;
#pragma unroll
        for (unsigned j = 0; j < 16; ++j) { const unsigned c = xb_ld(&bar[XB_XCNT(j)]); sum += c; cnt += (c > 0u) ? 1u : 0u; mine = (j == x) ? c : mine; }
        if (sum == G) break;
        __builtin_amdgcn_s_sleep(1);
        if ((++sp & 255u) == 0u) { if (xb_ld(&bar[XB_TMO])) break; if (sp > XB_SPIN_CAP) { atomicAdd(&bar[XB_TMO], 1u); break; } }
    }
    nloc = mine > 0u ? mine : 1u; nx = cnt > 0u ? cnt : 1u;
}

__device__ __forceinline__ void xcd_barrier(const XcdBarrier& b) {
    asm volatile("s_waitcnt vmcnt(0)" ::: "memory");
    __syncthreads();
    if (threadIdx.x == 0) {
        unsigned* bar = b.bar;
        __builtin_amdgcn_s_waitcnt(0);
        unsigned nloc = b.st[0], nx = b.st[1];
        if (nloc == 0u) { xcd_barrier_complete(bar, b.x, nloc, nx); b.st[0] = nloc; b.st[1] = nx; }
        const unsigned old = xb_add(&bar[XB_XSUB(b.x)], 1u);
        const unsigned gen = old / nloc;
        if (old + 1u == (gen + 1u) * nloc) {
            __builtin_amdgcn_fence(__ATOMIC_RELEASE, "agent");
            asm volatile("s_waitcnt vmcnt(0)" ::: "memory");
            const unsigned og = xb_add(&bar[XB_TOP], 1u);
            const unsigned tg = og / nx;
            if (og + 1u == (tg + 1u) * nx) xb_add(&bar[XB_TOPGEN], 1u);
            else XB_SPIN(xb_ld(&bar[XB_TOPGEN]) == tg, bar);
            __builtin_amdgcn_fence(__ATOMIC_ACQUIRE, "agent");
            xb_add(&bar[XB_XGEN(b.x)], 1u);
            asm volatile("s_waitcnt vmcnt(0)" ::: "memory");
        } else {
            XB_SPIN(xb_ld(&bar[XB_XGEN(b.x)]) == gen, bar);
            __builtin_amdgcn_fence(__ATOMIC_ACQUIRE, "agent");
            asm volatile("s_waitcnt vmcnt(0)" ::: "memory");
        }
    }
    __syncthreads();
}

struct Args { const float* in[22]; float* out; unsigned char* ws; int ph_lo, ph_hi; };

__device__ __forceinline__ void p0_prologue(const Args& a, LAS unsigned char* lds, int vcu, int G) {
    const int tid = threadIdx.x, lane = tid & 63, wave = tid >> 6;
    unsigned char* ws = a.ws;
    LAS float* scr = (LAS float*)(lds + wave * 16384);
    const int gw = vcu * 8 + wave, NGW = G * 8;
    constexpr int I_IN = 16 * 224, I_OA = 16 * 32, I_GL = 8 * 16, I_OS = 8 * 32, I_OUT = 16 * 32;
    constexpr int NITEMS = I_IN + I_OA + I_GL + I_OS + I_OUT;
    for (int it = gw; it < NITEMS; it += NGW) {
        int r = it;
        if (r < I_IN) { transpose_item(a.in[2], 1024, 7168, a.in[1], (bf16_t*)(ws + WS_WIN), scr, r, lane); continue; } r -= I_IN;
        if (r < I_OA) { transpose_item(a.in[8], 1024, 1024, nullptr, (bf16_t*)(ws + WS_WOATT), scr, r, lane); continue; } r -= I_OA;
        if (r < I_GL) { transpose_item(a.in[17], 512, 512, nullptr, (bf16_t*)(ws + WS_WGLU), scr, r, lane); continue; } r -= I_GL;
        if (r < I_OS) { transpose_item(a.in[19], 512, 1024, nullptr, (bf16_t*)(ws + WS_WOSSM), scr, r, lane); continue; } r -= I_OS;
        transpose_item(a.in[20], 1024, 1024, nullptr, (bf16_t*)(ws + WS_WOUT), scr, r, lane);
    }
    bf16_t* xb = (bf16_t*)a.out;
    for (int m0 = gw * 4; m0 < T; m0 += NGW * 4) {
        f32x4 v[4][4]; float s[4];
#pragma unroll
        for (int r = 0; r < 4; ++r) { const f32x4* xr = (const f32x4*)(a.in[0] + (size_t)(m0 + r) * 1024) + lane;
#pragma unroll
            for (int j = 0; j < 4; ++j) v[r][j] = __builtin_nontemporal_load(xr + 64 * j); }
#pragma unroll
        for (int r = 0; r < 4; ++r) { s[r] = 0.f;
#pragma unroll
            for (int j = 0; j < 4; ++j) s[r] += (v[r][j].x * v[r][j].x + v[r][j].y * v[r][j].y) + (v[r][j].z * v[r][j].z + v[r][j].w * v[r][j].w); }
#pragma unroll
        for (int o = 1; o < 64; o <<= 1) {
#pragma unroll
            for (int r = 0; r < 4; ++r) s[r] += __shfl_xor(s[r], o); }
#pragma unroll
        for (int r = 0; r < 4; ++r) { const float rstd = 1.f / sqrtf(s[r] * (1.f / 1024) + EPS);
            u32x2* o8 = (u32x2*)(xb + (size_t)(m0 + r) * 1024) + lane;
#pragma unroll
            for (int j = 0; j < 4; ++j) { u32x2 w; w.x = pk2(v[r][j].x * rstd, v[r][j].y * rstd); w.y = pk2(v[r][j].z * rstd, v[r][j].w * rstd); o8[64 * j] = w; } }
    }
    const int gt = vcu * 512 + tid, NGT = G * 512;
    for (int e = gt; e < 32 * 64 * 16; e += NGT) {
        const int it = e >> 4, h = e & 15, g = it >> 6, p = it & 63;
        const double dt = exp_d((double)a.in[11][g]);
        double lre = (double)a.in[9][it]; if (lre > -1e-4) lre = -1e-4;
        const double lim = (double)a.in[10][it];
        const double mag = exp_d(lre * dt); double sn, cs; sincos_d(lim * dt, sn, cs);
        const double lbr = mag * cs, lbi = mag * sn, nre = lbr - 1.0, den = lre * lre + lim * lim;
        const double cre = (nre * lre + lbi * lim) / den, cim = (lbi * lre - nre * lim) / den;
        if (h == 0) {
            float* lb = (float*)(ws + WS_LBAR); lb[2 * it] = (float)lbr; lb[2 * it + 1] = (float)lbi;
            const double m256 = exp_d(256.0 * lre * dt); double s2, c2; sincos_d(256.0 * lim * dt, s2, c2); float* l2 = (float*)(ws + WS_LB256); l2[2 * it] = (float)(m256 * c2); l2[2 * it + 1] = (float)(m256 * s2);
        }
        bf16_t* Bb = (bf16_t*)(ws + WS_BB); bf16_t* Cm = (bf16_t*)(ws + WS_CM);
        const double bre = (double)a.in[12][(size_t)it * 16 + h], bim = (double)a.in[13][(size_t)it * 16 + h];
        Bb[(size_t)(g * 128 + p) * 16 + h] = (bf16_t)f2bf((float)(cre * bre - cim * bim));
        Bb[(size_t)(g * 128 + 64 + p) * 16 + h] = (bf16_t)f2bf((float)(cre * bim + cim * bre));
        Cm[(size_t)(g * 16 + h) * 128 + p] = (bf16_t)f2bf(a.in[14][(size_t)(g * 16 + h) * 64 + p]);
        Cm[(size_t)(g * 16 + h) * 128 + 64 + p] = (bf16_t)f2bf(-a.in[15][(size_t)(g * 16 + h) * 64 + p]);
    }
    float* rowsq = (float*)(ws + WS_ROWSQ);
    for (int i = gt; i < T; i += NGT) rowsq[i] = 0.f;
}

typedef short v4i16_t __attribute__((ext_vector_type(4)));
__device__ __forceinline__ s16x4 tr16(LAS const unsigned char* p) { return __builtin_bit_cast(s16x4, __builtin_amdgcn_ds_read_tr16_b64_v4i16((LAS v4i16_t*)(LAS unsigned char*)p)); }
__device__ __forceinline__ void ssm_phase(LAS unsigned char* lds, const bf16_t* U, const float* lbar, const float* lb256, const bf16_t* Bb, const bf16_t* Cm, const float* dsk, bf16_t* YS, int unit0, int ustride) {
    const int tid = threadIdx.x, lane = tid & 63, c = lane & 31, hh = lane >> 5, wave = tid >> 6;
    constexpr int IP = 72, IB = 32 * IP, NBLK = 16;
    LAS unsigned char* img = lds + wave * (4 * IB);
    LAS float* ends = (LAS float*)(lds + 8 * 4 * IB);
    const int q_ = (lane & 15) >> 2, p_ = lane & 3, blk_ = (lane >> 4) & 1;
    f32x16 zero;
#pragma unroll
    for (int i = 0; i < 16; ++i) zero[i] = 0.f;
    for (int unit = unit0; unit < 256; unit += ustride) {
        const int g = unit >> 3, bp = unit & 7;
        bf16x8 bfr[4];
#pragma unroll
        for (int cb = 0; cb < 4; ++cb) bfr[cb] = *(const bf16x8*)(Bb + ((size_t)(g * 128 + cb * 32 + c) * 16 + 8 * hh));
        f32x2v ar, ai;
        ar.x = lbar[2 * (g * 64 + c)]; ai.x = lbar[2 * (g * 64 + c) + 1]; ar.y = lbar[2 * (g * 64 + 32 + c)]; ai.y = lbar[2 * (g * 64 + 32 + c) + 1];
        const int seq = (c >> 2) & 1, tau = (c & 3) + 4 * (c >> 3);
        const bf16_t* up = U + ((size_t)((2 * bp + seq) * SEQ + wave * 256 + tau) * 512 + g * 16 + 8 * hh);
        bf16_t* yp = YS + ((size_t)((2 * bp + seq) * SEQ + wave * 256 + tau) * 512 + g * 16 + 4 * hh);
        f32x2v xr = {0.f, 0.f}, xi = {0.f, 0.f};
        {
            bf16x8 a0 = *(const bf16x8*)up, a1 = *(const bf16x8*)(up + 1 * 8192), a2 = *(const bf16x8*)(up + 2 * 8192), a3 = *(const bf16x8*)(up + 3 * 8192);
            for (int blk = 0; blk < NBLK; ++blk) {
                const bf16x8 au = a0; a0 = a1; a1 = a2; a2 = a3; if (blk + 4 < NBLK) a3 = *(const bf16x8*)(up + (size_t)(blk + 4) * 8192);
                f32x16 acc[4];
#pragma unroll
                for (int cb = 0; cb < 4; ++cb) acc[cb] = MFMA32(au, bfr[cb], zero);
#pragma unroll
                for (int i = 0; i < 16; ++i) {
                    const f32x2v br = {acc[0][i], acc[1][i]}, bi = {acc[2][i], acc[3][i]};
                    const f32x2v nr = ar * xr - ai * xi + br, ni = ar * xi + ai * xr + bi;
                    xr = nr; xi = ni;
                }
            }
        }
        ends[(wave * 4 + 0) * 64 + lane] = xr.x; ends[(wave * 4 + 1) * 64 + lane] = xr.y; ends[(wave * 4 + 2) * 64 + lane] = xi.x; ends[(wave * 4 + 3) * 64 + lane] = xi.y;
        __syncthreads();
        {
            f32x2v Lr, Li; Lr.x = lb256[2 * (g * 64 + c)]; Li.x = lb256[2 * (g * 64 + c) + 1]; Lr.y = lb256[2 * (g * 64 + 32 + c)]; Li.y = lb256[2 * (g * 64 + 32 + c) + 1];
            xr = (f32x2v){0.f, 0.f}; xi = (f32x2v){0.f, 0.f};
            for (int i = 0; i < wave; ++i) {
                const f32x2v er = {ends[(i * 4 + 0) * 64 + lane], ends[(i * 4 + 1) * 64 + lane]}, ei = {ends[(i * 4 + 2) * 64 + lane], ends[(i * 4 + 3) * 64 + lane]};
                const f32x2v nr = Lr * xr - Li * xi + er, ni = Lr * xi + Li * xr + ei; xr = nr; xi = ni;
            }
        }
        bf16x8 cfr[8], dhi, dlo;
#pragma unroll
        for (int ks = 0; ks < 8; ++ks) { bf16x8 v = *(const bf16x8*)(Cm + ((size_t)(g * 16 + (c & 15)) * 128 + 16 * ks + 8 * hh));
#pragma unroll
            for (int e = 0; e < 8; ++e) cfr[ks][e] = (c < 16) ? v[e] : (short)0; }
        { const float d = dsk[g * 16 + (c & 15)]; const unsigned dh = f2bf(d); const unsigned dl = f2bf(d - __builtin_bit_cast(float, dh << 16));
          const bool on = (c < 16) && ((c >> 3) == hh);
#pragma unroll
          for (int e = 0; e < 8; ++e) { const bool m = on && (e == (c & 7)); dhi[e] = m ? (short)dh : (short)0; dlo[e] = m ? (short)dl : (short)0; } }
        {
            bf16x8 a0 = *(const bf16x8*)up, a1 = *(const bf16x8*)(up + 1 * 8192), a2 = *(const bf16x8*)(up + 2 * 8192), a3 = *(const bf16x8*)(up + 3 * 8192);
            for (int blk = 0; blk < NBLK; ++blk) {
                const bf16x8 au = a0; a0 = a1; a1 = a2; a2 = a3; if (blk + 4 < NBLK) a3 = *(const bf16x8*)(up + (size_t)(blk + 4) * 8192);
                f32x16 acc[4];
#pragma unroll
                for (int cb = 0; cb < 4; ++cb) acc[cb] = MFMA32(au, bfr[cb], zero);
#pragma unroll
                for (int i = 0; i < 16; ++i) {
                    const f32x2v br = {acc[0][i], acc[1][i]}, bi = {acc[2][i], acc[3][i]};
                    const f32x2v nr = ar * xr - ai * xi + br, ni = ar * xi + ai * xr + bi;
                    xr = nr; xi = ni; acc[0][i] = xr.x; acc[1][i] = xr.y; acc[2][i] = xi.x; acc[3][i] = xi.y;
                }
#pragma unroll
                for (int cb = 0; cb < 4; ++cb)
#pragma unroll
                    for (int g4 = 0; g4 < 4; ++g4) { u32x2 w; w.x = cvt_pk_bf16(acc[cb][4 * g4], acc[cb][4 * g4 + 1]); w.y = cvt_pk_bf16(acc[cb][4 * g4 + 2], acc[cb][4 * g4 + 3]);
                        *(LAS u32x2*)(img + cb * IB + c * IP + 8 * (2 * g4 + hh)) = w; }
                asm volatile("s_waitcnt lgkmcnt(0)" ::: "memory");
                f32x16 Y = MFMA32(dhi, au, zero); Y = MFMA32(dlo, au, Y);
#pragma unroll
                for (int cb = 0; cb < 4; ++cb)
#pragma unroll
                    for (int s = 0; s < 2; ++s) { LAS const unsigned char* rp = img + cb * IB + (16 * s + 8 * hh + q_) * IP + 8 * (4 * blk_ + p_);
                        const s16x4 lo = tr16(rp), hi = tr16(rp + 4 * IP);
                        const bf16x8 xa = __builtin_shufflevector(lo, hi, 0, 1, 2, 3, 4, 5, 6, 7);
                        Y = MFMA32(cfr[cb * 2 + s], xa, Y); }
                asm volatile("s_waitcnt lgkmcnt(0)" ::: "memory");
                { float ge[8];
#pragma unroll
                  for (int i = 0; i < 8; ++i) { const float y = Y[i]; const float z = 1.5957691216057308f * (y + 0.044715f * y * y * y); ge[i] = y * sigm(z); }
                  u32x2 w0, w1; w0.x = cvt_pk_bf16(ge[0], ge[1]); w0.y = cvt_pk_bf16(ge[2], ge[3]); w1.x = cvt_pk_bf16(ge[4], ge[5]); w1.y = cvt_pk_bf16(ge[6], ge[7]);
                  bf16_t* yo = yp + (size_t)(blk * 16) * 512;
                  *(u32x2*)yo = w0; *(u32x2*)(yo + 8) = w1; }
            }
        }
        __syncthreads();
    }
}

__device__ __forceinline__ void attn_tile(const bool FAST, LAS const unsigned char* kb, int kvb, int qa, int hh, int r32, int c, int vrow, int vbyte, float slope2,
                                          const bf16x8 (&qf)[4], f32x16 (&O)[4], float& l, float& Mref, bool& first) {
    constexpr int KP = 272, VP = 320, KBYTES = 64 * KP;
    LAS const unsigned char* vl = kb + KBYTES + vrow * VP + vbyte;
    const float c0 = slope2 * (float)(kvb + 4 * hh - qa) - Mref, c1 = c0 + 32.f * slope2;
    s16x4 va[2][8];
#define VLOAD(set, cb) do { _Pragma("unroll") for (int s = 0; s < 4; ++s) { va[set][2 * s] = tr16(vl + (16 * s) * VP + (cb) * 64); va[set][2 * s + 1] = tr16(vl + (16 * s + 8) * VP + (cb) * 64); } } while (0)
#define VMMA(set, cb) do { _Pragma("unroll") for (int s = 0; s < 4; ++s) { const bf16x8 vf = __builtin_shufflevector(va[set][2 * s], va[set][2 * s + 1], 0, 1, 2, 3, 4, 5, 6, 7); O[cb] = MFMA32(vf, pk[s], O[cb]); } } while (0)
    f32x16 p0, p1;
#pragma unroll
    for (int i = 0; i < 16; ++i) { p0[i] = __builtin_fmaf(slope2, (float)((i & 3) + 8 * (i >> 2)), c0); p1[i] = __builtin_fmaf(slope2, (float)((i & 3) + 8 * (i >> 2)), c1); }
#pragma unroll
    for (int ks = 0; ks < 4; ++ks) { LAS const unsigned char* kp = kb + r32 * KP + (c * 64 + 16 * ks + 8 * hh) * 2;
        const bf16x8 k0 = *(LAS const bf16x8*)kp, k1 = *(LAS const bf16x8*)(kp + 32 * KP);
        p0 = MFMA32(k0, qf[ks], p0); p1 = MFMA32(k1, qf[ks], p1); }
    VLOAD(0, 0);
    if (first) {
#pragma unroll
        for (int i = 0; i < 16; ++i) { const int kv = kvb + 4 * hh + (i & 3) + 8 * (i >> 2); if (kv > qa) p0[i] = -INFINITY; if (kv + 32 > qa) p1[i] = -INFINITY; }
    }
    if (!FAST) {
    float me = fmaxf(p0[0], p1[0]);
#pragma unroll
    for (int i = 1; i < 16; ++i) me = fmaxf(me, fmaxf(p0[i], p1[i]));
    { auto rr = __builtin_amdgcn_permlane32_swap(__float_as_uint(me), __float_as_uint(me), false, false); me = fmaxf(__uint_as_float(rr[0]), __uint_as_float(rr[1])); }
    if (first || __any(me > 8.f)) {
        const float dl = first ? me : fmaxf(me, 0.f); const float f = __builtin_amdgcn_exp2f(-dl);
#pragma unroll
        for (int cb = 0; cb < 4; ++cb) O[cb] = O[cb] * f;
        l *= f; Mref += dl;
#pragma unroll
        for (int i = 0; i < 16; ++i) { p0[i] -= dl; p1[i] -= dl; }
    }
    }
    first = false;
    float sacc = 0.f;
#pragma unroll
    for (int i = 0; i < 16; ++i) { p0[i] = __builtin_amdgcn_exp2f(p0[i]); p1[i] = __builtin_amdgcn_exp2f(p1[i]); sacc += p0[i] + p1[i]; }
    l += sacc;
    bf16x8 pk[4];
#pragma unroll
    for (int s = 0; s < 2; ++s) { u32x4 w0, w1;
        w0.x = cvt_pk_bf16(p0[8 * s], p0[8 * s + 1]); w0.y = cvt_pk_bf16(p0[8 * s + 2], p0[8 * s + 3]); w0.z = cvt_pk_bf16(p0[8 * s + 4], p0[8 * s + 5]); w0.w = cvt_pk_bf16(p0[8 * s + 6], p0[8 * s + 7]);
        w1.x = cvt_pk_bf16(p1[8 * s], p1[8 * s + 1]); w1.y = cvt_pk_bf16(p1[8 * s + 2], p1[8 * s + 3]); w1.z = cvt_pk_bf16(p1[8 * s + 4], p1[8 * s + 5]); w1.w = cvt_pk_bf16(p1[8 * s + 6], p1[8 * s + 7]);
        pk[s] = __builtin_bit_cast(bf16x8, w0); pk[2 + s] = __builtin_bit_cast(bf16x8, w1); }
    __builtin_amdgcn_sched_barrier(0);
    VLOAD(1, 1); __builtin_amdgcn_sched_barrier(0);
    VMMA(0, 0); __builtin_amdgcn_sched_barrier(0);
    VLOAD(0, 2); __builtin_amdgcn_sched_barrier(0);
    VMMA(1, 1); __builtin_amdgcn_sched_barrier(0);
    VLOAD(1, 3); __builtin_amdgcn_sched_barrier(0);
    VMMA(0, 2); __builtin_amdgcn_sched_barrier(0);
    VMMA(1, 3);
#undef VMMA
#undef VLOAD
}

__device__ __forceinline__ void attn_phase(LAS unsigned char* lds, const bf16_t* Q, const bf16_t* Kp, const bf16_t* Vp, const bf16_t* SZ, bf16_t* AG, const float* subln_g, float lam, unsigned* qctr, const unsigned* kmaxp) {
    const int tid = threadIdx.x, lane = tid & 63, r32 = lane & 31, hh = lane >> 5;
    const int wave = __builtin_amdgcn_readfirstlane(tid >> 6), c = wave & 1, j = wave >> 1;
    constexpr int KP = 272, VP = 320, KBYTES = 64 * KP, BUFB = KBYTES + 64 * VP, EXCH = 2 * BUFB;
    static_assert(EXCH + 4 * 16384 + 64 <= LDS_BYTES - 64, "attention LDS");
    const int sr0 = tid >> 4, sch = tid & 15;
    const int vrow = 4 * hh + ((lane & 15) >> 2), vbyte = 32 * ((lane >> 4) & 1) + 8 * (lane & 3);
    const float Kb = sqrtf(2.f * __builtin_bit_cast(float, __hip_atomic_load(kmaxp, __ATOMIC_RELAXED, __HIP_MEMORY_SCOPE_AGENT))) * 1.02f;
    LAS float* dsh = (LAS float*)(lds + EXCH + 4 * 16384);
    LAS int* nxt_slot = (LAS int*)(dsh + 8);
    if (tid == 0) *nxt_slot = (int)atomicAdd(qctr, 1u);
    __syncthreads();
    int cur = *nxt_slot;
    __syncthreads();
    while (cur < 2048) {
        {
            int nxt_reg = 0;
            if (tid == 0) nxt_reg = (int)atomicAdd(qctr, 1u);
            const int qb = 15 - (cur >> 7), bh = cur & 127, b = bh >> 3, h = bh & 7;
            const long rowbase = (long)b * SEQ; const int q0 = qb * 128, NT = 2 * (qb + 1);
            const int qa = q0 + 32 * j + r32;
            const bf16_t* Qw = Q + (rowbase + qa) * 1024 + h * 128 + c * 64 + 8 * hh;
            bf16x8 qf[4];
#pragma unroll
            for (int ks = 0; ks < 4; ++ks) qf[ks] = *(const bf16x8*)(Qw + 16 * ks);
            const float slope2 = exp2f(-(float)(h + 1)) * 1.4426950408889634f;
            const bf16_t* Kg = Kp + rowbase * 1024 + h * 128 + sch * 8; const bf16_t* Vg = Vp + rowbase * 1024 + h * 128 + sch * 8;
            u32x4 ak0, ak1, av0, av1, bk0, bk1, bv0, bv1;
#define LOADT(S, t) do { const size_t r_ = (size_t)((t) * 64 + sr0) * 1024; S##k0 = *(const u32x4*)(Kg + r_); S##k1 = *(const u32x4*)(Kg + r_ + 32 * 1024); S##v0 = *(const u32x4*)(Vg + r_); S##v1 = *(const u32x4*)(Vg + r_ + 32 * 1024); } while (0)
            LOADT(a, NT - 1); LOADT(b, NT - 2);
            float Bi;
            { float qn = 0.f;
#pragma unroll
              for (int ks = 0; ks < 4; ++ks)
#pragma unroll
                  for (int e2 = 0; e2 < 8; ++e2) { const float v = __builtin_bit_cast(float, ((unsigned)(unsigned short)qf[ks][e2]) << 16); qn += v * v; }
              qn += __shfl_xor(qn, 32);
              Bi = sqrtf(qn) * Kb;
              float dcut = (2.f * Bi + 40.f) / slope2;
#pragma unroll
              for (int o = 1; o < 32; o <<= 1) dcut = fmaxf(dcut, __shfl_xor(dcut, o));
              if (lane == 0) dsh[wave] = dcut; }
            f32x16 O[4];
#pragma unroll
            for (int cb = 0; cb < 4; ++cb)
#pragma unroll
                for (int i = 0; i < 16; ++i) O[cb][i] = 0.f;
            float l = 0.f, Mref = 0.f; bool first = true;
#define STORET(S, bf) do { LAS unsigned char* kb_ = lds + (bf) * BUFB; *(LAS u32x4*)(kb_ + sr0 * KP + sch * 16) = S##k0; *(LAS u32x4*)(kb_ + (sr0 + 32) * KP + sch * 16) = S##k1; \
        *(LAS u32x4*)(kb_ + KBYTES + sr0 * VP + sch * 16) = S##v0; *(LAS u32x4*)(kb_ + KBYTES + (sr0 + 32) * VP + sch * 16) = S##v1; } while (0)
            STORET(a, 0); if (NT >= 3) LOADT(a, NT - 3);
            __syncthreads();
            int NTe = NT; bool fast = false;
            { float dm = dsh[0];
#pragma unroll
              for (int w2 = 1; w2 < 8; ++w2) dm = fmaxf(dm, dsh[w2]);
              const float lim = (float)(q0 - 63) - dm;
              if (lim >= 0.f) { const int tlo = (int)floorf(lim * (1.f / 64)) + 1; NTe = NT - tlo; if (NTe < 2) NTe = 2; }
              fast = (dm * slope2 - 40.f) * 0.5f < 55.f; }
            if (fast) Mref = Bi;
            const int qtop = q0 + 32 * j + 31;
#define ATT_LOOP(FF) do { \
            for (int it = 0; it < NTe; it += 2) { \
                const int t = NT - 1 - it; \
                if (64 * t <= qtop) { attn_tile(FF, lds, 64 * t, qa, hh, r32, c, vrow, vbyte, slope2, qf, O, l, Mref, first); } \
                if (it + 1 < NTe) STORET(b, 1); \
                if (it + 3 < NTe) LOADT(b, t - 3); \
                __syncthreads(); \
                if (it + 1 >= NTe) break; \
                if (64 * (t - 1) <= qtop) { attn_tile(FF, lds + BUFB, 64 * (t - 1), qa, hh, r32, c, vrow, vbyte, slope2, qf, O, l, Mref, first); } \
                if (it + 2 < NTe) STORET(a, 0); \
                if (it + 4 < NTe) LOADT(a, t - 4); \
                __syncthreads(); \
            } \
            } while (0)
            ATT_LOOP(fast);
#undef ATT_LOOP
#undef LOADT
#undef STORET
            const float lt = l + __shfl_xor(l, 32); const float inv = 1.f / lt;
            LAS float* ex = (LAS float*)(lds + EXCH + j * 16384);
            if (c == 1) {
#pragma unroll
                for (int cb = 0; cb < 4; ++cb)
#pragma unroll
                    for (int i = 0; i < 16; ++i) ex[(cb * 16 + i) * 64 + lane] = O[cb][i] * inv;
            }
            __syncthreads();
            if (c == 0) {
                float ss = 0.f;
#pragma unroll
                for (int cb = 0; cb < 4; ++cb)
#pragma unroll
                    for (int i = 0; i < 16; ++i) { const float d = O[cb][i] * inv - lam * ex[(cb * 16 + i) * 64 + lane]; O[cb][i] = d; ss += d * d; }
                ss += __shfl_xor(ss, 32);
                const float rs = 0.8f / sqrtf(ss * (1.f / 128) + EPS);
                const size_t orow = (size_t)(rowbase + qa) * 1024 + h * 128;
#pragma unroll
                for (int cb = 0; cb < 4; ++cb)
#pragma unroll
                    for (int g4 = 0; g4 < 4; ++g4) { const int dv = 32 * cb + 8 * g4 + 4 * hh;
                        const f32x4 gs = *(const f32x4*)(subln_g + dv); const u32x2 z = *(const u32x2*)(SZ + orow + dv);
                        u32x2 w; w.x = cvt_pk_bf16(O[cb][4 * g4] * rs * gs[0] * bflo(z.x), O[cb][4 * g4 + 1] * rs * gs[1] * bfhi(z.x));
                        w.y = cvt_pk_bf16(O[cb][4 * g4 + 2] * rs * gs[2] * bflo(z.y), O[cb][4 * g4 + 3] * rs * gs[3] * bfhi(z.y));
                        *(u32x2*)(AG + orow + dv) = w; }
            }
            if (tid == 0) *nxt_slot = nxt_reg;
        }
        __syncthreads();
        cur = *nxt_slot;
    }
}

__global__ void __launch_bounds__(512, 2) fwd_mega(Args a) {
    extern __shared__ __attribute__((aligned(16))) unsigned char lds_raw[];
    LAS unsigned char* lds = (LAS unsigned char*)lds_raw;
    cg::grid_group grid = cg::this_grid();
    volatile LAS unsigned* MISC = (volatile LAS unsigned*)(lds + LDS_BYTES - 64);
    if (threadIdx.x < 16) MISC[threadIdx.x] = 0u;
    __syncthreads();
    XcdBarrier bar = xcd_barrier_post((unsigned*)(a.ws + WS_BAR), MISC);
    const int G = gridDim.x, bx = blockIdx.x;
    const int vcu = (G % 8 == 0) ? (bx % 8) * (G / 8) + bx / 8 : bx;
    const int lo = a.ph_lo, hi = a.ph_hi;
    unsigned char* ws = a.ws;
    bf16_t* proj = (bf16_t*)(ws + WS_PROJ);
    bf16_t* xb = (bf16_t*)a.out; bf16_t* ag = (bf16_t*)a.out + (size_t)T * 1024;
    bf16_t* ys = (bf16_t*)(ws + WS_YS);
#define IN(k) (lo <= (k) && (k) < hi)
#define SEAM(k) do { if (IN(k) && IN((k) + 1)) { if (lo < 0) grid.sync(); else xcd_barrier(bar); } } while (0)
    if (IN(0)) p0_prologue(a, lds, vcu, G);
    SEAM(0);
    if (IN(1)) {
        __syncthreads();
        pg8::Gemm g{xb, (const bf16_t*)(ws + WS_WIN), T, NIN, 1024}; pg8::StaticOrder S; S.init(T, NIN, G, bx, 3);
        EpiProj E{proj, (unsigned*)(ws + WS_KMAX)};
        pg8::gemm_phase<EpiProj, pg8::StaticOrder, true, true>(lds, g, S, E);
    }
    SEAM(1);
    if (IN(2)) {
        __syncthreads();
        ssm_phase(lds, proj + PU, (const float*)(ws + WS_LBAR), (const float*)(ws + WS_LB256), (const bf16_t*)(ws + WS_BB), (const bf16_t*)(ws + WS_CM), a.in[16], ys, bx, G);
        __syncthreads();
        const int lane = threadIdx.x & 63;
        const float s1 = wave_sum(a.in[3][lane] * a.in[4][lane]), s2 = wave_sum(a.in[5][lane] * a.in[6][lane]);
        const float lam = expf(s1) - expf(s2) + 0.2f;
        attn_phase(lds, proj + PQ, proj + PK, proj + PV, proj + PSZA, ag, a.in[7], lam, (unsigned*)(ws + WS_QCTR), (const unsigned*)(ws + WS_KMAX));
    }
    SEAM(2);
    if (IN(3)) {
        __syncthreads();
        pg8::Gemm g{ys, (const bf16_t*)(ws + WS_WGLU), T, 512, 512}; pg8::StaticOrder S; S.init(T, 512, G, bx);
        EpiGlu E{ys, proj + PSZS, a.in[18], proj + PS};
        pg8::gemm_phase<EpiGlu, pg8::StaticOrder, true, true>(lds, g, S, E);
    }
    SEAM(3);
    if (IN(4)) {
        __syncthreads();
        { pg8::Gemm g{ag, (const bf16_t*)(ws + WS_WOATT), T, 1024, 1024}; pg8::StaticOrder S; S.init(T, 1024, G, bx);
          EpiGate<0> E{proj + PGA, nullptr, proj + PY1};
          pg8::gemm_phase<EpiGate<0>, pg8::StaticOrder, true, true>(lds, g, S, E); }
        __syncthreads();
        { pg8::Gemm g{proj + PS, (const bf16_t*)(ws + WS_WOSSM), T, 1024, 512}; pg8::StaticOrder S; S.init(T, 1024, G, bx);
          EpiGate<1> E{proj + PGS, proj + PY1, proj + PMG};
          pg8::gemm_phase<EpiGate<1>, pg8::StaticOrder, true, true>(lds, g, S, E); }
    }
    SEAM(4);
    if (IN(5)) {
        __syncthreads();
        pg8::Gemm g{proj + PMG, (const bf16_t*)(ws + WS_WOUT), T, 1024, 1024}; pg8::StaticOrder S; S.init(T, 1024, G, bx);
        EpiOutNorm E{a.in[0], a.out, (float*)(ws + WS_ROWSQ), (unsigned*)(ws + WS_CNT), a.in[21]};
        pg8::gemm_phase<EpiOutNorm, pg8::StaticOrder, true, true>(lds, g, S, E);
    }
#undef IN
#undef SEAM
}

extern "C" void kernel_launch(void* const* d_in, const int* in_sizes, int n_in, void* d_out, int out_size, void* d_ws, size_t ws_size, hipStream_t stream) {
    static int grid = 0;
    if (grid == 0) {
        if (n_in != 22 || out_size != T * 1024 || ws_size < WS_END) { fprintf(stderr, "kernel_launch: unexpected shapes (n_in %d out %d ws %zu)\n", n_in, out_size, ws_size); grid = -1; return; }
        int dev = 0, cus = 0, per_cu = 0;
        (void)hipGetDevice(&dev); (void)hipDeviceGetAttribute(&cus, hipDeviceAttributeMultiprocessorCount, dev);
        if (hipFuncSetAttribute((const void*)fwd_mega, hipFuncAttributeMaxDynamicSharedMemorySize, LDS_BYTES) != hipSuccess) { fprintf(stderr, "kernel_launch: hipFuncSetAttribute failed\n"); grid = -1; return; }
        if (hipOccupancyMaxActiveBlocksPerMultiprocessor(&per_cu, (const void*)fwd_mega, 512, LDS_BYTES) != hipSuccess || per_cu < 1) { fprintf(stderr, "kernel_launch: occupancy query failed (%d)\n", per_cu); grid = -1; return; }
        grid = cus * per_cu;
    }
    if (grid < 0) return;
    if (hipMemsetAsync((char*)d_ws + WS_BAR, 0, 32768, stream) != hipSuccess) { fprintf(stderr, "kernel_launch: memset failed\n"); return; }
    Args a{};
    for (int i = 0; i < 22; ++i) a.in[i] = (const float*)d_in[i];
    a.out = (float*)d_out; a.ws = (unsigned char*)d_ws; a.ph_lo = 0; a.ph_hi = 6;
    void* args[] = {&a};
    hipError_t e = hipLaunchCooperativeKernel((const void*)fwd_mega, dim3(grid), dim3(512), args, LDS_BYTES, stream);
    if (e != hipSuccess) fprintf(stderr, "kernel_launch: cooperative launch failed: %s (grid %d)\n", hipGetErrorString(e), grid);
}
```

```cpp
#include <hip/hip_runtime.h>
#include <hip/hip_cooperative_groups.h>
#include <cstdio>
#include <cstdint>
namespace cg = cooperative_groups;
namespace pg8 {
#define PG8_LAS __attribute__((address_space(3)))
typedef unsigned short bf16_t;
typedef short bf16x8 __attribute__((ext_vector_type(8)));
typedef float f32x4 __attribute__((ext_vector_type(4)));
typedef unsigned u32x4 __attribute__((ext_vector_type(4)));
constexpr int BM = 256, BK = 64, HALF = 128, HTB = HALF * BK * 2  , STAGE_BYTES = 8 * HTB, NXCD = 8, WGM = 8;

__host__ __device__ __forceinline__ int lds_byte(int r, int c) { const int st = (r >> 4) * 2 + (c >> 5), rr = r & 15, cc = c & 31, ob = rr * 64 + cc * 2; return st * 1024 + (ob ^ (((ob >> 9) & 1) << 5)); }
__host__ __device__ __forceinline__ void stage_rc(int b, int& R, int& C) { const int st = b / 1024, sb = b % 1024, swz = sb ^ (((sb >> 9) & 1) << 5); R = (st >> 1) * 16 + swz / 64; C = (st & 1) * 32 + (swz % 64) / 2; }
__host__ __device__ __forceinline__ int perm32(int rho) { const int n = rho >> 4, i = rho & 15; return 8 * (i >> 2) + 4 * n + (i & 3); }

struct Unit { int pm, pn; };
struct Gemm { const bf16_t* A; const bf16_t* Bt; int M, N, K; };
struct StaticOrder {
    int nM, nN, nwg, G, c, wgm;
    __host__ __device__ void init(int M, int N, int G_, int c_, int wgm_ = WGM) { nM = M / BM; nN = N / BM; nwg = nM * nN; G = G_; c = c_; wgm = wgm_; }
    __host__ __device__ bool next(int i, Unit& u) const {
        const long L = (long)i * G + c; if (L >= nwg) return false;
        int wgid = (int)L; { const int q = nwg / NXCD, r = nwg % NXCD, xcd = wgid % NXCD, off = wgid / NXCD; wgid = (xcd < r ? xcd * (q + 1) : r * (q + 1) + (xcd - r) * q) + off; }
        const int nig = wgm * nN, gid = wgid / nig, fm = gid * wgm, gsz = (nM - fm) < wgm ? (nM - fm) : wgm;
        u.pm = fm + ((wgid % nig) % gsz); u.pn = (wgid % nig) / gsz; return true;
    }
    __device__ __forceinline__ void a_ready(const Unit&) const {}
    __device__ __forceinline__ void done(const Unit&) const {}
};
__device__ __forceinline__ unsigned cvt_pk_bf16(float lo, float hi) { unsigned r; asm volatile("v_cvt_pk_bf16_f32 %0, %1, %2" : "=v"(r) : "v"(lo), "v"(hi)); return r; }
typedef float f32x2 __attribute__((ext_vector_type(2)));
template <class Epi, class Sched, bool ALIGN_EPI = false, bool SP2 = false>
__device__ __forceinline__ void gemm_phase(PG8_LAS unsigned char* lds, const Gemm g, const Sched& S, const Epi& E) {
    const int tid = threadIdx.x, wid = __builtin_amdgcn_readfirstlane(tid >> 6), lane = tid & 63, wr = wid >> 2, wc = wid & 3, fr = lane & 15, fq = lane >> 4;
    const int K = g.K, nt = K / BK;
    unsigned voffA[2], voffB[2];
#pragma unroll
    for (int i = 0; i < 2; ++i) { int R, C; stage_rc(tid * 16 + i * 8192, R, C); const int Rb = Epi::PERM ? ((R & ~31) + perm32(R & 31)) : R;
        voffA[i] = (unsigned)(R * K + C) * 2u; voffB[i] = (unsigned)(Rb * K + C) * 2u; }
    const size_t kstep = (size_t)(BK * 2);
    const size_t hstep = (size_t)HALF * K * 2;
    const size_t tstep = 2 * hstep;
    const unsigned ldsw = (unsigned)wid * 1024u;
    const int aoff = lds_byte(wr * 64 + fr, fq * 8), boff = lds_byte(wc * 32 + fr, fq * 8);
#define PG8_SA(b, h) (((b) * 2 + (h)) * HTB)
#define PG8_SB(b, h) ((4 + (b) * 2 + (h)) * HTB)
#define PG8_STAGE(bufoff, gbase, voff) do { _Pragma("unroll") for (int _i = 0; _i < 2; ++_i) \
        __builtin_amdgcn_global_load_lds((const unsigned*)((const char*)(gbase) + (voff)[_i]), (PG8_LAS unsigned*)(lds + (bufoff) + ldsw + _i * 8192), 16, 0, 0); } while (0)
#define PG8_LDA(dst, b, h) do { _Pragma("unroll") for (int m = 0; m < 4; ++m) _Pragma("unroll") for (int k = 0; k < 2; ++k) dst[m][k] = *(const PG8_LAS bf16x8*)(lds + PG8_SA(b, h) + aoff + m * 2048 + k * 1024); } while (0)
#define PG8_LDB(dst, b, h) do { _Pragma("unroll") for (int n = 0; n < 2; ++n) _Pragma("unroll") for (int k = 0; k < 2; ++k) dst[n][k] = *(const PG8_LAS bf16x8*)(lds + PG8_SB(b, h) + boff + n * 2048 + k * 1024); } while (0)
#define PG8_MMA(ai, bj, At, Bt) do { __builtin_amdgcn_s_setprio(1); _Pragma("unroll") for (int m = 0; m < 4; ++m) _Pragma("unroll") for (int n = 0; n < 2; ++n) _Pragma("unroll") for (int k = 0; k < 2; ++k) \
        acc[ai][bj][m][n] = __builtin_amdgcn_mfma_f32_16x16x32_bf16(Bt[n][k], At[m][k], acc[ai][bj][m][n], 0, 0, 0); __builtin_amdgcn_s_setprio(0); } while (0)
#define PG8_WAIT_V(n) asm volatile("s_waitcnt vmcnt(" #n ")" ::: "memory")
#define PG8_WAIT_L(n) asm volatile("s_waitcnt lgkmcnt(" #n ")" ::: "memory")
#define PG8_BAR __builtin_amdgcn_s_barrier()
#define PG8_SCHED __builtin_amdgcn_sched_barrier(0)
    Unit cur, nxt; int ui = 0;
    if (!S.next(0, cur)) return;
    f32x4 acc[2][2][4][2];
#pragma unroll
    for (int a = 0; a < 2; ++a)
#pragma unroll
        for (int b = 0; b < 2; ++b)
#pragma unroll
            for (int m = 0; m < 4; ++m)
#pragma unroll
                for (int n = 0; n < 2; ++n) acc[a][b][m][n] = (f32x4){0.f, 0.f, 0.f, 0.f};
    bf16x8 At[4][2], B0[2][2], B1[2][2];
    const char* cA = (const char*)g.A + (size_t)cur.pm * tstep; const char* cB = (const char*)g.Bt + (size_t)cur.pn * tstep;
    S.a_ready(cur);
    if constexpr (SP2) {
        PG8_STAGE(PG8_SB(0, 0), cB, voffB); PG8_STAGE(PG8_SB(0, 1), cB + hstep, voffB); PG8_STAGE(PG8_SA(0, 0), cA, voffA); PG8_STAGE(PG8_SA(0, 1), cA + hstep, voffA);
        if (wr == 1) PG8_BAR;
        PG8_WAIT_V(2); PG8_BAR;
        PG8_STAGE(PG8_SB(1, 0), cB + kstep, voffB); PG8_STAGE(PG8_SA(1, 0), cA + kstep, voffA); PG8_STAGE(PG8_SB(1, 1), cB + hstep + kstep, voffB);
        PG8_WAIT_V(6); PG8_BAR;
    } else {
        PG8_STAGE(PG8_SB(0, 0), cB, voffB); PG8_STAGE(PG8_SA(0, 0), cA, voffA); PG8_STAGE(PG8_SB(0, 1), cB + hstep, voffB); PG8_STAGE(PG8_SA(0, 1), cA + hstep, voffA);
        if (wr == 1) PG8_BAR;
        PG8_WAIT_V(4); PG8_BAR;
        PG8_STAGE(PG8_SB(1, 0), cB + kstep, voffB); PG8_STAGE(PG8_SA(1, 0), cA + kstep, voffA); PG8_STAGE(PG8_SB(1, 1), cB + hstep + kstep, voffB);
        PG8_WAIT_V(6); PG8_BAR;
    }
    for (;;) {
        const bool has_next = S.next(ui + 1, nxt);
        const char* nA = has_next ? (const char*)g.A + (size_t)nxt.pm * tstep : cA; const char* nB = has_next ? (const char*)g.Bt + (size_t)nxt.pn * tstep : cB;
        for (int t = 0; t < nt; t += 2) {
            const bool last = (t == nt - 2);
            const char* a1 = cA + (size_t)(t + 1) * kstep;
            const char* a2 = last ? nA : cA + (size_t)(t + 2) * kstep; const char* b2 = last ? nB : cB + (size_t)(t + 2) * kstep;
            const char* a3 = a2 + kstep; const char* b3 = b2 + kstep;
            if (last && has_next) S.a_ready(nxt);
            if constexpr (SP2) {
            PG8_LDB(B0, 0, 0); PG8_LDB(B1, 0, 1); PG8_SCHED; PG8_LDA(At, 0, 0); PG8_STAGE(PG8_SA(1, 1), a1 + hstep, voffA);
            PG8_WAIT_V(8); PG8_WAIT_L(0); PG8_BAR; PG8_MMA(0, 0, At, B0); PG8_MMA(0, 1, At, B1); PG8_BAR; PG8_SCHED;
            PG8_LDA(At, 0, 1); PG8_STAGE(PG8_SB(0, 0), b2, voffB); PG8_STAGE(PG8_SB(0, 1), b2 + hstep, voffB); PG8_STAGE(PG8_SA(0, 0), a2, voffA);
            PG8_WAIT_V(8); PG8_WAIT_L(0); PG8_BAR; PG8_MMA(1, 0, At, B0); PG8_MMA(1, 1, At, B1); PG8_BAR; PG8_SCHED;
            PG8_LDB(B0, 1, 0); PG8_LDB(B1, 1, 1); PG8_SCHED; PG8_LDA(At, 1, 0); PG8_STAGE(PG8_SA(0, 1), a2 + hstep, voffA);
            PG8_WAIT_V(8); PG8_WAIT_L(0); PG8_BAR; PG8_MMA(0, 0, At, B0); PG8_MMA(0, 1, At, B1); PG8_BAR; PG8_SCHED;
            PG8_LDA(At, 1, 1); PG8_STAGE(PG8_SB(1, 0), b3, voffB); PG8_STAGE(PG8_SB(1, 1), b3 + hstep, voffB); PG8_STAGE(PG8_SA(1, 0), a3, voffA);
            PG8_WAIT_V(8); PG8_WAIT_L(0); PG8_BAR; PG8_MMA(1, 0, At, B0); PG8_MMA(1, 1, At, B1); PG8_BAR; PG8_SCHED;
            } else {
            PG8_LDB(B0, 0, 0); PG8_SCHED; PG8_LDA(At, 0, 0); PG8_STAGE(PG8_SA(1, 1), a1 + hstep, voffA);
            PG8_WAIT_L(8); PG8_BAR; PG8_WAIT_L(0); PG8_MMA(0, 0, At, B0); PG8_BAR; PG8_SCHED;
            PG8_LDB(B1, 0, 1); PG8_STAGE(PG8_SB(0, 0), b2, voffB);
            PG8_BAR; PG8_WAIT_L(0); PG8_MMA(0, 1, At, B1); PG8_BAR;
            PG8_LDA(At, 0, 1); PG8_STAGE(PG8_SA(0, 0), a2, voffA);
            PG8_BAR; PG8_WAIT_L(0); PG8_MMA(1, 0, At, B0); PG8_BAR; PG8_SCHED;
            PG8_STAGE(PG8_SB(0, 1), b2 + hstep, voffB);
            PG8_WAIT_V(6); PG8_BAR; PG8_MMA(1, 1, At, B1); PG8_BAR;
            PG8_LDB(B0, 1, 0); PG8_SCHED; PG8_LDA(At, 1, 0); PG8_STAGE(PG8_SA(0, 1), a2 + hstep, voffA);
            PG8_WAIT_L(8); PG8_BAR; PG8_WAIT_L(0); PG8_MMA(0, 0, At, B0); PG8_BAR; PG8_SCHED;
            PG8_LDB(B1, 1, 1); PG8_STAGE(PG8_SB(1, 0), b3, voffB);
            PG8_BAR; PG8_WAIT_L(0); PG8_MMA(0, 1, At, B1); PG8_BAR;
            PG8_LDA(At, 1, 1); PG8_STAGE(PG8_SA(1, 0), a3, voffA);
            PG8_BAR; PG8_WAIT_L(0); PG8_MMA(1, 0, At, B0); PG8_BAR; PG8_SCHED;
            PG8_STAGE(PG8_SB(1, 1), b3 + hstep, voffB);
            PG8_WAIT_V(6); PG8_BAR; PG8_MMA(1, 1, At, B1); PG8_BAR;
            }
        }
        if constexpr (ALIGN_EPI) { if (wr == 0) PG8_BAR; }
        if constexpr (!Epi::AFTER_DRAIN) { E(acc, cur, wr, wc, fr, fq); S.done(cur); }
        if (!has_next) break;
#pragma unroll
        for (int a = 0; a < 2; ++a)
#pragma unroll
            for (int b = 0; b < 2; ++b)
#pragma unroll
                for (int m = 0; m < 4; ++m)
#pragma unroll
                    for (int n = 0; n < 2; ++n) acc[a][b][m][n] = (f32x4){0.f, 0.f, 0.f, 0.f};
        cur = nxt; cA = nA; cB = nB; ++ui;
        if constexpr (ALIGN_EPI) { if (wr == 1) PG8_BAR; }
    }
    PG8_WAIT_V(0);
    if constexpr (!ALIGN_EPI) { if (wr == 0) PG8_BAR; }
    PG8_BAR;
    if constexpr (Epi::AFTER_DRAIN) { E.fused(acc, cur, wr, wc, fr, fq, lds, wid, lane); S.done(cur); }
#undef PG8_SA
#undef PG8_SB
#undef PG8_STAGE
#undef PG8_LDA
#undef PG8_LDB
#undef PG8_MMA
#undef PG8_WAIT_V
#undef PG8_WAIT_L
#undef PG8_BAR
#undef PG8_SCHED
}
}

using pg8::bf16_t; using pg8::bf16x8; using pg8::f32x4; using pg8::u32x4; using pg8::Unit; using pg8::cvt_pk_bf16;
#define LAS __attribute__((address_space(3)))
typedef float f32x16 __attribute__((ext_vector_type(16)));
typedef float f32x2v __attribute__((ext_vector_type(2)));
typedef short s16x4 __attribute__((ext_vector_type(4)));
typedef unsigned u32x2 __attribute__((ext_vector_type(2)));
#define MFMA32(a, b, c) __builtin_amdgcn_mfma_f32_32x32x16_bf16((a), (b), (c), 0, 0, 0)

constexpr int T = 32768, SEQ = 2048, DM = 1024, NIN = 7168, SW = 512;
constexpr size_t MiB = 1u << 20;
constexpr size_t WS_ROWSQ = 0;
constexpr size_t WS_BAR = 512 * 1024;
constexpr size_t WS_QCTR = WS_BAR + 24576, WS_KMAX = WS_BAR + 24576 + 64;
constexpr size_t WS_CNT = WS_BAR + 16384;
constexpr size_t WS_WIN = 2 * MiB, WS_WOATT = 16 * MiB, WS_WGLU = 18 * MiB, WS_WOSSM = 19 * MiB, WS_WOUT = 20 * MiB;
constexpr size_t WS_LBAR = 22 * MiB, WS_LB256 = 22 * MiB + 32 * 1024, WS_BB = 22 * MiB + 64 * 1024, WS_CM = 22 * MiB + 256 * 1024;
constexpr size_t WS_YS = 24 * MiB;
constexpr size_t WS_PROJ = 64 * MiB;
constexpr size_t WS_END = 512 * MiB;
constexpr size_t PQ = 0, PK = (size_t)T * 1024, PV = 2 * (size_t)T * 1024, PSZA = 3 * (size_t)T * 1024, PU = 4 * (size_t)T * 1024,
                 PSZS = PU + (size_t)T * 512, PGA = 5 * (size_t)T * 1024, PGS = 6 * (size_t)T * 1024;
constexpr size_t PS = PQ, PY1 = PK, PMG = PV;
constexpr int LDS_BYTES = 147456;
constexpr float C2 = 0.125f * 1.4426950408889634f;
constexpr float EPS = 1e-5f;

__device__ __forceinline__ unsigned f2bf(float f) { unsigned u = __builtin_bit_cast(unsigned, f); return (u + 0x7fffu + ((u >> 16) & 1u)) >> 16; }
__device__ __forceinline__ unsigned pk2(float lo, float hi) { return f2bf(lo) | (f2bf(hi) << 16); }
__device__ __forceinline__ float bflo(unsigned w) { return __builtin_bit_cast(float, w << 16); }
__device__ __forceinline__ float bfhi(unsigned w) { return __builtin_bit_cast(float, w & 0xffff0000u); }
__device__ __forceinline__ float sigm(float x) { return __builtin_amdgcn_rcpf(1.f + __expf(-x)); }
__device__ __forceinline__ float wave_sum(float v) {
#pragma unroll
    for (int o = 1; o < 64; o <<= 1) v += __shfl_xor(v, o);
    return v;
}
__device__ __forceinline__ u32x4 pack8(const f32x4& a, const f32x4& b) { u32x4 w; w.x = cvt_pk_bf16(a[0], a[1]); w.y = cvt_pk_bf16(a[2], a[3]); w.z = cvt_pk_bf16(b[0], b[1]); w.w = cvt_pk_bf16(b[2], b[3]); return w; }
__device__ __forceinline__ void unpack8(const u32x4& w, f32x4& a, f32x4& b) { a = (f32x4){bflo(w.x), bfhi(w.x), bflo(w.y), bfhi(w.y)}; b = (f32x4){bflo(w.z), bfhi(w.z), bflo(w.w), bfhi(w.w)}; }

struct EpiProj {
    static constexpr bool PERM = true, AFTER_DRAIN = false;
    bf16_t* proj; unsigned* kmax;
    __device__ __forceinline__ void operator()(const f32x4 (&acc)[2][2][4][2], const Unit& u, int wr, int wc, int fr, int fq) const {
        const int colt = u.pn * 256; int start, pitch, act; size_t off;
        if (colt < 1024) { start = 0; pitch = 1024; off = PQ; act = 3; }
        else if (colt < 2048) { start = 1024; pitch = 1024; off = PK; act = 4; }
        else if (colt < 3072) { start = 2048; pitch = 1024; off = PV; act = 0; }
        else if (colt < 4096) { start = 3072; pitch = 1024; off = PSZA; act = 1; }
        else if (colt < 4608) { start = 4096; pitch = 512; off = PU; act = 0; }
        else if (colt < 5120) { start = 4608; pitch = 512; off = PSZS; act = 1; }
        else if (colt < 6144) { start = 5120; pitch = 1024; off = PGA; act = 2; }
        else { start = 6144; pitch = 1024; off = PGS; act = 2; }
        const int row0 = u.pm * 256 + wr * 64 + fr, col0 = colt - start + wc * 32 + 8 * fq;
        bf16_t* base = proj + off; float kn = 0.f;
#pragma unroll
        for (int ai = 0; ai < 2; ++ai)
#pragma unroll
            for (int m = 0; m < 4; ++m) { bf16_t* rowp = base + (size_t)(row0 + ai * 128 + m * 16) * pitch + col0;
#pragma unroll
                for (int bj = 0; bj < 2; ++bj) { f32x4 v0 = acc[ai][bj][m][0], v1 = acc[ai][bj][m][1];
                    if (act == 1) {
#pragma unroll
                        for (int e = 0; e < 4; ++e) { v0[e] = v0[e] * sigm(v0[e]); v1[e] = v1[e] * sigm(v1[e]); } }
                    else if (act == 2) {
#pragma unroll
                        for (int e = 0; e < 4; ++e) { v0[e] = sigm(v0[e]); v1[e] = sigm(v1[e]); } }
                    else if (act == 3) { v0 = v0 * C2; v1 = v1 * C2; }
                    else if (act == 4) { float ss = (v0[0] * v0[0] + v0[1] * v0[1]) + (v0[2] * v0[2] + v0[3] * v0[3]) + (v1[0] * v1[0] + v1[1] * v1[1]) + (v1[2] * v1[2] + v1[3] * v1[3]);
                        ss += __shfl_xor(ss, 16); ss += __shfl_xor(ss, 32); kn = fmaxf(kn, ss); }
                    *(u32x4*)(rowp + bj * 128) = pack8(v0, v1); } }
        if (act == 4) {
#pragma unroll
            for (int o = 1; o < 16; o <<= 1) kn = fmaxf(kn, __shfl_xor(kn, o));
            if ((threadIdx.x & 63) == 0) atomicMax(kmax, __builtin_bit_cast(unsigned, kn));
        }
    }
};
struct EpiGlu {
    static constexpr bool PERM = true, AFTER_DRAIN = false;
    const bf16_t* ys; const bf16_t* szs; const float* bglu; bf16_t* S;
    __device__ __forceinline__ void operator()(const f32x4 (&acc)[2][2][4][2], const Unit& u, int wr, int wc, int fr, int fq) const {
        const int row0 = u.pm * 256 + wr * 64 + fr, col0 = u.pn * 256 + wc * 32 + 8 * fq;
#pragma unroll
        for (int ai = 0; ai < 2; ++ai)
#pragma unroll
            for (int m = 0; m < 4; ++m) { const size_t ro = (size_t)(row0 + ai * 128 + m * 16) * 512 + col0;
#pragma unroll
                for (int bj = 0; bj < 2; ++bj) { const size_t o = ro + bj * 128;
                    const f32x4 b0 = *(const f32x4*)(bglu + col0 + bj * 128), b1 = *(const f32x4*)(bglu + col0 + bj * 128 + 4);
                    f32x4 y0, y1, z0, z1; unpack8(*(const u32x4*)(ys + o), y0, y1); unpack8(*(const u32x4*)(szs + o), z0, z1);
                    f32x4 v0 = acc[ai][bj][m][0] + b0, v1 = acc[ai][bj][m][1] + b1;
#pragma unroll
                    for (int e = 0; e < 4; ++e) { v0[e] = y0[e] * sigm(v0[e]) * z0[e]; v1[e] = y1[e] * sigm(v1[e]) * z1[e]; }
                    *(u32x4*)(S + o) = pack8(v0, v1); } }
    }
};
template <int MODE> struct EpiGate {
    static constexpr bool PERM = true, AFTER_DRAIN = false;
    const bf16_t* gate; const bf16_t* y1; bf16_t* O;
    __device__ __forceinline__ void operator()(const f32x4 (&acc)[2][2][4][2], const Unit& u, int wr, int wc, int fr, int fq) const {
        const int row0 = u.pm * 256 + wr * 64 + fr, col0 = u.pn * 256 + wc * 32 + 8 * fq;
#pragma unroll
        for (int ai = 0; ai < 2; ++ai)
#pragma unroll
            for (int m = 0; m < 4; ++m) { const size_t ro = (size_t)(row0 + ai * 128 + m * 16) * 1024 + col0;
#pragma unroll
                for (int bj = 0; bj < 2; ++bj) { const size_t o = ro + bj * 128;
                    f32x4 g0, g1; unpack8(*(const u32x4*)(gate + o), g0, g1);
                    f32x4 v0 = acc[ai][bj][m][0] * g0, v1 = acc[ai][bj][m][1] * g1;
                    if (MODE == 1) { f32x4 p0, p1; unpack8(*(const u32x4*)(y1 + o), p0, p1); v0 += p0; v1 += p1; }
                    *(u32x4*)(O + o) = pack8(v0, v1); } }
    }
};
struct EpiOutNorm {
    static constexpr bool PERM = true, AFTER_DRAIN = false;
    const float* x; float* out; float* rowsq; unsigned* cnt; const float* fg;
    __device__ __forceinline__ void operator()(const f32x4 (&acc_c)[2][2][4][2], const Unit& u, int wr, int wc, int fr, int fq) const {
        f32x4 (&acc)[2][2][4][2] = const_cast<f32x4 (&)[2][2][4][2]>(acc_c);
        const int row0 = u.pm * 256 + wr * 64 + fr, col0 = u.pn * 256 + wc * 32 + 8 * fq;
        float olds[8];
#pragma unroll
        for (int e = 0; e < 8; ++e) olds[e] = 0.f;
#pragma unroll
        for (int ai = 0; ai < 2; ++ai)
#pragma unroll
            for (int m = 0; m < 4; ++m) { const int row = row0 + ai * 128 + m * 16; const size_t ro = (size_t)row * 1024 + col0; float ss = 0.f;
#pragma unroll
                for (int bj = 0; bj < 2; ++bj) { const size_t o = ro + bj * 128;
                    const f32x4 r0 = *(const f32x4*)(x + o) + acc[ai][bj][m][0], r1 = *(const f32x4*)(x + o + 4) + acc[ai][bj][m][1];
                    acc[ai][bj][m][0] = r0; acc[ai][bj][m][1] = r1;
                    ss += (r0[0] * r0[0] + r0[1] * r0[1]) + (r0[2] * r0[2] + r0[3] * r0[3]) + (r1[0] * r1[0] + r1[1] * r1[1]) + (r1[2] * r1[2] + r1[3] * r1[3]); }
                ss += __shfl_xor(ss, 16); ss += __shfl_xor(ss, 32);
                if (fq == 0) olds[ai * 4 + m] = unsafeAtomicAdd(rowsq + row, ss); }
        asm volatile("s_waitcnt vmcnt(0)" :: "v"(olds[0]), "v"(olds[1]), "v"(olds[2]), "v"(olds[3]), "v"(olds[4]), "v"(olds[5]), "v"(olds[6]), "v"(olds[7]) : "memory");
        unsigned* c = cnt + u.pm * 16;
        if ((threadIdx.x & 63) == 0) __hip_atomic_fetch_add(c, 1u, __ATOMIC_RELAXED, __HIP_MEMORY_SCOPE_AGENT);
        { unsigned sp = 0; while (__hip_atomic_load(c, __ATOMIC_RELAXED, __HIP_MEMORY_SCOPE_AGENT) < 32u) { __builtin_amdgcn_s_sleep(4); if (++sp > (1u << 22)) break; } }
        asm volatile("s_waitcnt vmcnt(0)" ::: "memory");
        f32x4 g[2][2];
#pragma unroll
        for (int bj = 0; bj < 2; ++bj) { g[bj][0] = *(const f32x4*)(fg + col0 + bj * 128); g[bj][1] = *(const f32x4*)(fg + col0 + bj * 128 + 4); }
#pragma unroll
        for (int ai = 0; ai < 2; ++ai)
#pragma unroll
            for (int m = 0; m < 4; ++m) { const int row = row0 + ai * 128 + m * 16; const size_t ro = (size_t)row * 1024 + col0;
                const float rs = 1.f / sqrtf(__hip_atomic_load(rowsq + row, __ATOMIC_RELAXED, __HIP_MEMORY_SCOPE_AGENT) * (1.f / 1024) + EPS);
#pragma unroll
                for (int bj = 0; bj < 2; ++bj) { const size_t o = ro + bj * 128;
                    *(f32x4*)(out + o) = acc[ai][bj][m][0] * rs * g[bj][0]; *(f32x4*)(out + o + 4) = acc[ai][bj][m][1] * rs * g[bj][1]; } }
    }
};

__device__ __forceinline__ void transpose_item(const float* W, int K, int N, const float* gk, bf16_t* WT, LAS float* scr, int item, int lane) {
    const int nblk = N / 32, kb = item / nblk, nb = item % nblk, k0 = 64 * kb, n0 = 32 * nb;
#pragma unroll 8
    for (int i = 0; i < 32; ++i) { const int kk = 2 * i + (lane >> 5); float v = __builtin_nontemporal_load(W + (size_t)(k0 + kk) * N + n0 + (lane & 31)); if (gk) v *= gk[k0 + kk]; scr[kk * 33 + (lane & 31)] = v; }
    asm volatile("s_waitcnt lgkmcnt(0)" ::: "memory");
    const int c = lane & 7;
#pragma unroll
    for (int j = 0; j < 4; ++j) { const int n = (lane >> 3) + 8 * j; const LAS float* s = scr + (8 * c) * 33 + n;
        u32x4 o; o.x = pk2(s[0 * 33], s[1 * 33]); o.y = pk2(s[2 * 33], s[3 * 33]); o.z = pk2(s[4 * 33], s[5 * 33]); o.w = pk2(s[6 * 33], s[7 * 33]);
        *(u32x4*)(WT + (size_t)(n0 + n) * K + k0 + 8 * c) = o; }
    asm volatile("s_waitcnt lgkmcnt(0)" ::: "memory");
}
__device__ __forceinline__ void sincos_small(double r, double& s, double& c) {
    const double r2 = r * r;
    s = r * (1.0 + r2 * (-1.0 / 6 + r2 * (1.0 / 120 + r2 * (-1.0 / 5040 + r2 * (1.0 / 362880 + r2 * (-1.0 / 39916800 + r2 * (1.0 / 6227020800.0)))))));
    c = 1.0 + r2 * (-0.5 + r2 * (1.0 / 24 + r2 * (-1.0 / 720 + r2 * (1.0 / 40320 + r2 * (-1.0 / 3628800 + r2 * (1.0 / 479001600.0 + r2 * (-1.0 / 87178291200.0)))))));
}
__device__ __forceinline__ void sincos_d(double th, double& s, double& c) {
    const double PI2 = 1.5707963267948966192313216916398;
    const double k = rint(th / PI2); const double r = th - k * PI2;
    double sr, cr; sincos_small(r, sr, cr);
    const int q = ((int)k) & 3;
    if (q == 0) { s = sr; c = cr; } else if (q == 1) { s = cr; c = -sr; } else if (q == 2) { s = -sr; c = -cr; } else { s = -cr; c = sr; }
}
__device__ __forceinline__ double exp_d(double x) {
    const double y = x * (1.0 / 256);
    double e = 1.0 + y * (1.0 + y * (0.5 + y * (1.0 / 6 + y * (1.0 / 24 + y * (1.0 / 120 + y * (1.0 / 720 + y * (1.0 / 5040 + y * (1.0 / 40320 + y * (1.0 / 362880 + y * (1.0 / 3628800))))))))));
    e *= e; e *= e; e *= e; e *= e; e *= e; e *= e; e *= e; e *= e; return e;
}
#define XB_TMO      128
#define XB_XCNT(j)  (256  + 64 * (j))
#define XB_XSUB(j)  (1280 + 64 * (j))
#define XB_XGEN(j)  (2304 + 64 * (j))
#define XB_TOP      3328
#define XB_TOPGEN   3392
#define XCD_BAR_WORDS 3456
#define XB_SPIN_CAP (1u << 18)

__device__ __forceinline__ unsigned xb_ld(unsigned* p)              { return __hip_atomic_load(p, __ATOMIC_RELAXED, __HIP_MEMORY_SCOPE_AGENT); }
__device__ __forceinline__ unsigned xb_add(unsigned* p, unsigned v) { return __hip_atomic_fetch_add(p, v, __ATOMIC_RELAXED, __HIP_MEMORY_SCOPE_AGENT); }
__device__ __forceinline__ unsigned xb_xcc_id() { return (unsigned)__builtin_amdgcn_s_getreg((3 << 11) | 20) & 0xFu; }
#define XB_SPIN(cond, bar) do { unsigned _sp = 0; while (cond) { __builtin_amdgcn_s_sleep(1); \
    if ((++_sp & 255u) == 0u) { if (xb_ld(&(bar)[XB_TMO])) break; if (_sp > XB_SPIN_CAP) { atomicAdd(&(bar)[XB_TMO], 1u); break; } } } } while (0)

struct XcdBarrier {
    unsigned* bar; unsigned x;
    volatile LAS unsigned* st;
};

__device__ __forceinline__ XcdBarrier xcd_barrier_post(unsigned* bar, volatile LAS unsigned* st) {
    XcdBarrier b; b.bar = bar; b.x = xb_xcc_id(); b.st = st;
    if (threadIdx.x == 0) (void)xb_add(&bar[XB_XCNT(b.x)], 1u);
    return b;
}
__device__ __forceinline__ void xcd_barrier_complete(unsigned* bar, unsigned x, unsigned& nloc, unsigned& nx) {
    const unsigned G = gridDim.x * gridDim.y * gridDim.z;
    unsigned sum, cnt, mine, sp = 0u;
    for (;;) {
        sum = 0u; cnt = 0u; mine = 0u;
#pragma unroll
        for (unsigned j = 0; j < 16; ++j) { const unsigned c = xb_ld(&bar[XB_XCNT(j)]); sum += c; cnt += (c > 0u) ? 1u : 0u; mine = (j == x) ? c : mine; }
        if (sum == G) break;
        __builtin_amdgcn_s_sleep(1);
        if ((++sp & 255u) == 0u) { if (xb_ld(&bar[XB_TMO])) break; if (sp > XB_SPIN_CAP) { atomicAdd(&bar[XB_TMO], 1u); break; } }
    }
    nloc = mine > 0u ? mine : 1u; nx = cnt > 0u ? cnt : 1u;
}

__device__ __forceinline__ void xcd_barrier(const XcdBarrier& b) {
    asm volatile("s_waitcnt vmcnt(0)" ::: "memory");
    __syncthreads();
    if (threadIdx.x == 0) {
        unsigned* bar = b.bar;
        __builtin_amdgcn_s_waitcnt(0);
        unsigned nloc = b.st[0], nx = b.st[1];
        if (nloc == 0u) { xcd_barrier_complete(bar, b.x, nloc, nx); b.st[0] = nloc; b.st[1] = nx; }
        const unsigned old = xb_add(&bar[XB_XSUB(b.x)], 1u);
        const unsigned gen = old / nloc;
        if (old + 1u == (gen + 1u) * nloc) {
            __builtin_amdgcn_fence(__ATOMIC_RELEASE, "agent");
            asm volatile("s_waitcnt vmcnt(0)" ::: "memory");
            const unsigned og = xb_add(&bar[XB_TOP], 1u);
            const unsigned tg = og / nx;
            if (og + 1u == (tg + 1u) * nx) xb_add(&bar[XB_TOPGEN], 1u);
            else XB_SPIN(xb_ld(&bar[XB_TOPGEN]) == tg, bar);
            __builtin_amdgcn_fence(__ATOMIC_ACQUIRE, "agent");
            xb_add(&bar[XB_XGEN(b.x)], 1u);
            asm volatile("s_waitcnt vmcnt(0)" ::: "memory");
        } else {
            XB_SPIN(xb_ld(&bar[XB_XGEN(b.x)]) == gen, bar);
            __builtin_amdgcn_fence(__ATOMIC_ACQUIRE, "agent");
            asm volatile("s_waitcnt vmcnt(0)" ::: "memory");
        }
    }
    __syncthreads();
}

struct Args { const float* in[22]; float* out; unsigned char* ws; int ph_lo, ph_hi; };

__device__ __forceinline__ void p0_prologue(const Args& a, LAS unsigned char* lds, int vcu, int G) {
    const int tid = threadIdx.x, lane = tid & 63, wave = tid >> 6;
    unsigned char* ws = a.ws;
    LAS float* scr = (LAS float*)(lds + wave * 16384);
    const int gw = vcu * 8 + wave, NGW = G * 8;
    constexpr int I_IN = 16 * 224, I_OA = 16 * 32, I_GL = 8 * 16, I_OS = 8 * 32, I_OUT = 16 * 32;
    constexpr int NITEMS = I_IN + I_OA + I_GL + I_OS + I_OUT;
    for (int it = gw; it < NITEMS; it += NGW) {
        int r = it;
        if (r < I_IN) { transpose_item(a.in[2], 1024, 7168, a.in[1], (bf16_t*)(ws + WS_WIN), scr, r, lane); continue; } r -= I_IN;
        if (r < I_OA) { transpose_item(a.in[8], 1024, 1024, nullptr, (bf16_t*)(ws + WS_WOATT), scr, r, lane); continue; } r -= I_OA;
        if (r < I_GL) { transpose_item(a.in[17], 512, 512, nullptr, (bf16_t*)(ws + WS_WGLU), scr, r, lane); continue; } r -= I_GL;
        if (r < I_OS) { transpose_item(a.in[19], 512, 1024, nullptr, (bf16_t*)(ws + WS_WOSSM), scr, r, lane); continue; } r -= I_OS;
        transpose_item(a.in[20], 1024, 1024, nullptr, (bf16_t*)(ws + WS_WOUT), scr, r, lane);
    }
    bf16_t* xb = (bf16_t*)a.out;
    for (int m0 = gw * 8; m0 < T; m0 += NGW * 8) {
        f32x4 v[8][4]; float s[8];
#pragma unroll
        for (int r = 0; r < 8; ++r) { const f32x4* xr = (const f32x4*)(a.in[0] + (size_t)(m0 + r) * 1024) + lane;
#pragma unroll
            for (int j = 0; j < 4; ++j) v[r][j] = __builtin_nontemporal_load(xr + 64 * j); }
#pragma unroll
        for (int r = 0; r < 8; ++r) { s[r] = 0.f;
#pragma unroll
            for (int j = 0; j < 4; ++j) s[r] += (v[r][j].x * v[r][j].x + v[r][j].y * v[r][j].y) + (v[r][j].z * v[r][j].z + v[r][j].w * v[r][j].w); }
#pragma unroll
        for (int o = 1; o < 64; o <<= 1) {
#pragma unroll
            for (int r = 0; r < 8; ++r) s[r] += __shfl_xor(s[r], o); }
#pragma unroll
        for (int r = 0; r < 8; ++r) { const float rstd = 1.f / sqrtf(s[r] * (1.f / 1024) + EPS);
            u32x2* o8 = (u32x2*)(xb + (size_t)(m0 + r) * 1024) + lane;
#pragma unroll
            for (int j = 0; j < 4; ++j) { u32x2 w; w.x = pk2(v[r][j].x * rstd, v[r][j].y * rstd); w.y = pk2(v[r][j].z * rstd, v[r][j].w * rstd); o8[64 * j] = w; } }
    }
    const int gt = vcu * 512 + tid, NGT = G * 512;
    for (int e = gt; e < 32 * 64 * 16; e += NGT) {
        const int it = e >> 4, h = e & 15, g = it >> 6, p = it & 63;
        const double dt = exp_d((double)a.in[11][g]);
        double lre = (double)a.in[9][it]; if (lre > -1e-4) lre = -1e-4;
        const double lim = (double)a.in[10][it];
        const double mag = exp_d(lre * dt); double sn, cs; sincos_d(lim * dt, sn, cs);
        const double lbr = mag * cs, lbi = mag * sn, nre = lbr - 1.0, den = lre * lre + lim * lim;
        const double cre = (nre * lre + lbi * lim) / den, cim = (lbi * lre - nre * lim) / den;
        if (h == 0) {
            float* lb = (float*)(ws + WS_LBAR); lb[2 * it] = (float)lbr; lb[2 * it + 1] = (float)lbi;
            const double m256 = exp_d(256.0 * lre * dt); double s2, c2; sincos_d(256.0 * lim * dt, s2, c2); float* l2 = (float*)(ws + WS_LB256); l2[2 * it] = (float)(m256 * c2); l2[2 * it + 1] = (float)(m256 * s2);
        }
        bf16_t* Bb = (bf16_t*)(ws + WS_BB); bf16_t* Cm = (bf16_t*)(ws + WS_CM);
        const double bre = (double)a.in[12][(size_t)it * 16 + h], bim = (double)a.in[13][(size_t)it * 16 + h];
        Bb[(size_t)(g * 128 + p) * 16 + h] = (bf16_t)f2bf((float)(cre * bre - cim * bim));
        Bb[(size_t)(g * 128 + 64 + p) * 16 + h] = (bf16_t)f2bf((float)(cre * bim + cim * bre));
        Cm[(size_t)(g * 16 + h) * 128 + p] = (bf16_t)f2bf(a.in[14][(size_t)(g * 16 + h) * 64 + p]);
        Cm[(size_t)(g * 16 + h) * 128 + 64 + p] = (bf16_t)f2bf(-a.in[15][(size_t)(g * 16 + h) * 64 + p]);
    }
    float* rowsq = (float*)(ws + WS_ROWSQ);
    for (int i = gt; i < T; i += NGT) rowsq[i] = 0.f;
}

typedef short v4i16_t __attribute__((ext_vector_type(4)));
__device__ __forceinline__ s16x4 tr16(LAS const unsigned char* p) { return __builtin_bit_cast(s16x4, __builtin_amdgcn_ds_read_tr16_b64_v4i16((LAS v4i16_t*)(LAS unsigned char*)p)); }
__device__ __forceinline__ void ssm_phase(LAS unsigned char* lds, const bf16_t* U, const float* lbar, const float* lb256, const bf16_t* Bb, const bf16_t* Cm, const float* dsk, bf16_t* YS, int unit0, int ustride) {
    const int tid = threadIdx.x, lane = tid & 63, c = lane & 31, hh = lane >> 5, wave = tid >> 6;
    constexpr int IP = 72, IB = 32 * IP, NBLK = 16;
    LAS unsigned char* img = lds + wave * (4 * IB);
    LAS float* ends = (LAS float*)(lds + 8 * 4 * IB);
    const int q_ = (lane & 15) >> 2, p_ = lane & 3, blk_ = (lane >> 4) & 1;
    f32x16 zero;
#pragma unroll
    for (int i = 0; i < 16; ++i) zero[i] = 0.f;
    for (int unit = unit0; unit < 256; unit += ustride) {
        const int g = unit >> 3, bp = unit & 7;
        bf16x8 bfr[4];
#pragma unroll
        for (int cb = 0; cb < 4; ++cb) bfr[cb] = *(const bf16x8*)(Bb + ((size_t)(g * 128 + cb * 32 + c) * 16 + 8 * hh));
        f32x2v ar, ai;
        ar.x = lbar[2 * (g * 64 + c)]; ai.x = lbar[2 * (g * 64 + c) + 1]; ar.y = lbar[2 * (g * 64 + 32 + c)]; ai.y = lbar[2 * (g * 64 + 32 + c) + 1];
        const int seq = (c >> 2) & 1, tau = (c & 3) + 4 * (c >> 3);
        const bf16_t* up = U + ((size_t)((2 * bp + seq) * SEQ + wave * 256 + tau) * 512 + g * 16 + 8 * hh);
        bf16_t* yp = YS + ((size_t)((2 * bp + seq) * SEQ + wave * 256 + tau) * 512 + g * 16 + 4 * hh);
        f32x2v xr = {0.f, 0.f}, xi = {0.f, 0.f};
        {
            bf16x8 a0 = *(const bf16x8*)up, a1 = *(const bf16x8*)(up + 1 * 8192), a2 = *(const bf16x8*)(up + 2 * 8192), a3 = *(const bf16x8*)(up + 3 * 8192);
            for (int blk = 0; blk < NBLK; ++blk) {
                const bf16x8 au = a0; a0 = a1; a1 = a2; a2 = a3; if (blk + 4 < NBLK) a3 = *(const bf16x8*)(up + (size_t)(blk + 4) * 8192);
                f32x16 acc[4];
#pragma unroll
                for (int cb = 0; cb < 4; ++cb) acc[cb] = MFMA32(au, bfr[cb], zero);
#pragma unroll
                for (int i = 0; i < 16; ++i) {
                    const f32x2v br = {acc[0][i], acc[1][i]}, bi = {acc[2][i], acc[3][i]};
                    const f32x2v nr = ar * xr - ai * xi + br, ni = ar * xi + ai * xr + bi;
                    xr = nr; xi = ni;
                }
            }
        }
        ends[(wave * 4 + 0) * 64 + lane] = xr.x; ends[(wave * 4 + 1) * 64 + lane] = xr.y; ends[(wave * 4 + 2) * 64 + lane] = xi.x; ends[(wave * 4 + 3) * 64 + lane] = xi.y;
        __syncthreads();
        {
            f32x2v Lr, Li; Lr.x = lb256[2 * (g * 64 + c)]; Li.x = lb256[2 * (g * 64 + c) + 1]; Lr.y = lb256[2 * (g * 64 + 32 + c)]; Li.y = lb256[2 * (g * 64 + 32 + c) + 1];
            xr = (f32x2v){0.f, 0.f}; xi = (f32x2v){0.f, 0.f};
            for (int i = 0; i < wave; ++i) {
                const f32x2v er = {ends[(i * 4 + 0) * 64 + lane], ends[(i * 4 + 1) * 64 + lane]}, ei = {ends[(i * 4 + 2) * 64 + lane], ends[(i * 4 + 3) * 64 + lane]};
                const f32x2v nr = Lr * xr - Li * xi + er, ni = Lr * xi + Li * xr + ei; xr = nr; xi = ni;
            }
        }
        bf16x8 cfr[8], dhi, dlo;
#pragma unroll
        for (int ks = 0; ks < 8; ++ks) { bf16x8 v = *(const bf16x8*)(Cm + ((size_t)(g * 16 + (c & 15)) * 128 + 16 * ks + 8 * hh));
#pragma unroll
            for (int e = 0; e < 8; ++e) cfr[ks][e] = (c < 16) ? v[e] : (short)0; }
        { const float d = dsk[g * 16 + (c & 15)]; const unsigned dh = f2bf(d); const unsigned dl = f2bf(d - __builtin_bit_cast(float, dh << 16));
          const bool on = (c < 16) && ((c >> 3) == hh);
#pragma unroll
          for (int e = 0; e < 8; ++e) { const bool m = on && (e == (c & 7)); dhi[e] = m ? (short)dh : (short)0; dlo[e] = m ? (short)dl : (short)0; } }
        {
            bf16x8 a0 = *(const bf16x8*)up, a1 = *(const bf16x8*)(up + 1 * 8192), a2 = *(const bf16x8*)(up + 2 * 8192), a3 = *(const bf16x8*)(up + 3 * 8192);
            for (int blk = 0; blk < NBLK; ++blk) {
                const bf16x8 au = a0; a0 = a1; a1 = a2; a2 = a3; if (blk + 4 < NBLK) a3 = *(const bf16x8*)(up + (size_t)(blk + 4) * 8192);
                f32x16 acc[4];
#pragma unroll
                for (int cb = 0; cb < 4; ++cb) acc[cb] = MFMA32(au, bfr[cb], zero);
#pragma unroll
                for (int i = 0; i < 16; ++i) {
                    const f32x2v br = {acc[0][i], acc[1][i]}, bi = {acc[2][i], acc[3][i]};
                    const f32x2v nr = ar * xr - ai * xi + br, ni = ar * xi + ai * xr + bi;
                    xr = nr; xi = ni; acc[0][i] = xr.x; acc[1][i] = xr.y; acc[2][i] = xi.x; acc[3][i] = xi.y;
                }
#pragma unroll
                for (int cb = 0; cb < 4; ++cb)
#pragma unroll
                    for (int g4 = 0; g4 < 4; ++g4) { u32x2 w; w.x = cvt_pk_bf16(acc[cb][4 * g4], acc[cb][4 * g4 + 1]); w.y = cvt_pk_bf16(acc[cb][4 * g4 + 2], acc[cb][4 * g4 + 3]);
                        *(LAS u32x2*)(img + cb * IB + c * IP + 8 * (2 * g4 + hh)) = w; }
                asm volatile("s_waitcnt lgkmcnt(0)" ::: "memory");
                f32x16 Y = MFMA32(dhi, au, zero); Y = MFMA32(dlo, au, Y);
#pragma unroll
                for (int cb = 0; cb < 4; ++cb)
#pragma unroll
                    for (int s = 0; s < 2; ++s) { LAS const unsigned char* rp = img + cb * IB + (16 * s + 8 * hh + q_) * IP + 8 * (4 * blk_ + p_);
                        const s16x4 lo = tr16(rp), hi = tr16(rp + 4 * IP);
                        const bf16x8 xa = __builtin_shufflevector(lo, hi, 0, 1, 2, 3, 4, 5, 6, 7);
                        Y = MFMA32(cfr[cb * 2 + s], xa, Y); }
                asm volatile("s_waitcnt lgkmcnt(0)" ::: "memory");
                { float ge[8];
#pragma unroll
                  for (int i = 0; i < 8; ++i) { const float y = Y[i]; const float z = 1.5957691216057308f * (y + 0.044715f * y * y * y); ge[i] = y * sigm(z); }
                  u32x2 w0, w1; w0.x = cvt_pk_bf16(ge[0], ge[1]); w0.y = cvt_pk_bf16(ge[2], ge[3]); w1.x = cvt_pk_bf16(ge[4], ge[5]); w1.y = cvt_pk_bf16(ge[6], ge[7]);
                  bf16_t* yo = yp + (size_t)(blk * 16) * 512;
                  *(u32x2*)yo = w0; *(u32x2*)(yo + 8) = w1; }
            }
        }
        __syncthreads();
    }
}

__device__ __forceinline__ void attn_tile(const bool FAST, LAS const unsigned char* kb, int kvb, int qa, int hh, int r32, int c, int vrow, int vbyte, float slope2,
                                          const bf16x8 (&qf)[4], f32x16 (&O)[4], float& l, float& Mref, bool& first) {
    constexpr int KP = 272, VP = 320, KBYTES = 64 * KP;
    LAS const unsigned char* vl = kb + KBYTES + vrow * VP + vbyte;
    const float c0 = slope2 * (float)(kvb + 4 * hh - qa) - Mref, c1 = c0 + 32.f * slope2;
    s16x4 va[2][8];
#define VLOAD(set, cb) do { _Pragma("unroll") for (int s = 0; s < 4; ++s) { va[set][2 * s] = tr16(vl + (16 * s) * VP + (cb) * 64); va[set][2 * s + 1] = tr16(vl + (16 * s + 8) * VP + (cb) * 64); } } while (0)
#define VMMA(set, cb) do { _Pragma("unroll") for (int s = 0; s < 4; ++s) { const bf16x8 vf = __builtin_shufflevector(va[set][2 * s], va[set][2 * s + 1], 0, 1, 2, 3, 4, 5, 6, 7); O[cb] = MFMA32(vf, pk[s], O[cb]); } } while (0)
    f32x16 p0, p1;
#pragma unroll
    for (int i = 0; i < 16; ++i) { p0[i] = __builtin_fmaf(slope2, (float)((i & 3) + 8 * (i >> 2)), c0); p1[i] = __builtin_fmaf(slope2, (float)((i & 3) + 8 * (i >> 2)), c1); }
#pragma unroll
    for (int ks = 0; ks < 4; ++ks) { LAS const unsigned char* kp = kb + r32 * KP + (c * 64 + 16 * ks + 8 * hh) * 2;
        const bf16x8 k0 = *(LAS const bf16x8*)kp, k1 = *(LAS const bf16x8*)(kp + 32 * KP);
        p0 = MFMA32(k0, qf[ks], p0); p1 = MFMA32(k1, qf[ks], p1); }
    VLOAD(0, 0);
    if (first) {
#pragma unroll
        for (int i = 0; i < 16; ++i) { const int kv = kvb + 4 * hh + (i & 3) + 8 * (i >> 2); if (kv > qa) p0[i] = -INFINITY; if (kv + 32 > qa) p1[i] = -INFINITY; }
    }
    if (!FAST) {
    float me = fmaxf(p0[0], p1[0]);
#pragma unroll
    for (int i = 1; i < 16; ++i) me = fmaxf(me, fmaxf(p0[i], p1[i]));
    { auto rr = __builtin_amdgcn_permlane32_swap(__float_as_uint(me), __float_as_uint(me), false, false); me = fmaxf(__uint_as_float(rr[0]), __uint_as_float(rr[1])); }
    if (first || __any(me > 8.f)) {
        const float dl = first ? me : fmaxf(me, 0.f); const float f = __builtin_amdgcn_exp2f(-dl);
#pragma unroll
        for (int cb = 0; cb < 4; ++cb) O[cb] = O[cb] * f;
        l *= f; Mref += dl;
#pragma unroll
        for (int i = 0; i < 16; ++i) { p0[i] -= dl; p1[i] -= dl; }
    }
    }
    first = false;
    float sacc = 0.f;
#pragma unroll
    for (int i = 0; i < 16; ++i) { p0[i] = __builtin_amdgcn_exp2f(p0[i]); p1[i] = __builtin_amdgcn_exp2f(p1[i]); sacc += p0[i] + p1[i]; }
    l += sacc;
    bf16x8 pk[4];
#pragma unroll
    for (int s = 0; s < 2; ++s) { u32x4 w0, w1;
        w0.x = cvt_pk_bf16(p0[8 * s], p0[8 * s + 1]); w0.y = cvt_pk_bf16(p0[8 * s + 2], p0[8 * s + 3]); w0.z = cvt_pk_bf16(p0[8 * s + 4], p0[8 * s + 5]); w0.w = cvt_pk_bf16(p0[8 * s + 6], p0[8 * s + 7]);
        w1.x = cvt_pk_bf16(p1[8 * s], p1[8 * s + 1]); w1.y = cvt_pk_bf16(p1[8 * s + 2], p1[8 * s + 3]); w1.z = cvt_pk_bf16(p1[8 * s + 4], p1[8 * s + 5]); w1.w = cvt_pk_bf16(p1[8 * s + 6], p1[8 * s + 7]);
        pk[s] = __builtin_bit_cast(bf16x8, w0); pk[2 + s] = __builtin_bit_cast(bf16x8, w1); }
    __builtin_amdgcn_sched_barrier(0);
    VLOAD(1, 1); __builtin_amdgcn_sched_barrier(0);
    VMMA(0, 0); __builtin_amdgcn_sched_barrier(0);
    VLOAD(0, 2); __builtin_amdgcn_sched_barrier(0);
    VMMA(1, 1); __builtin_amdgcn_sched_barrier(0);
    VLOAD(1, 3); __builtin_amdgcn_sched_barrier(0);
    VMMA(0, 2); __builtin_amdgcn_sched_barrier(0);
    VMMA(1, 3);
#undef VMMA
#undef VLOAD
}

__device__ __forceinline__ void attn_phase(LAS unsigned char* lds, const bf16_t* Q, const bf16_t* Kp, const bf16_t* Vp, const bf16_t* SZ, bf16_t* AG, const float* subln_g, float lam, unsigned* qctr, const unsigned* kmaxp) {
    const int tid = threadIdx.x, lane = tid & 63, r32 = lane & 31, hh = lane >> 5;
    const int wave = __builtin_amdgcn_readfirstlane(tid >> 6), c = wave & 1, j = wave >> 1;
    constexpr int KP = 272, VP = 320, KBYTES = 64 * KP, BUFB = KBYTES + 64 * VP, EXCH = 2 * BUFB;
    static_assert(EXCH + 4 * 16384 + 64 <= LDS_BYTES - 64, "attention LDS");
    const int sr0 = tid >> 4, sch = tid & 15;
    const int vrow = 4 * hh + ((lane & 15) >> 2), vbyte = 32 * ((lane >> 4) & 1) + 8 * (lane & 3);
    const float Kb = sqrtf(2.f * __builtin_bit_cast(float, __hip_atomic_load(kmaxp, __ATOMIC_RELAXED, __HIP_MEMORY_SCOPE_AGENT))) * 1.02f;
    LAS float* dsh = (LAS float*)(lds + EXCH + 4 * 16384);
    LAS int* nxt_slot = (LAS int*)(dsh + 8);
    if (tid == 0) *nxt_slot = (int)atomicAdd(qctr, 1u);
    __syncthreads();
    int cur = *nxt_slot;
    __syncthreads();
    while (cur < 2048) {
        {
            int nxt_reg = 0;
            if (tid == 0) nxt_reg = (int)atomicAdd(qctr, 1u);
            const int qb = 15 - (cur >> 7), bh = cur & 127, b = bh >> 3, h = bh & 7;
            const long rowbase = (long)b * SEQ; const int q0 = qb * 128, NT = 2 * (qb + 1);
            const int qa = q0 + 32 * j + r32;
            const bf16_t* Qw = Q + (rowbase + qa) * 1024 + h * 128 + c * 64 + 8 * hh;
            bf16x8 qf[4];
#pragma unroll
            for (int ks = 0; ks < 4; ++ks) qf[ks] = *(const bf16x8*)(Qw + 16 * ks);
            const float slope2 = exp2f(-(float)(h + 1)) * 1.4426950408889634f;
            const bf16_t* Kg = Kp + rowbase * 1024 + h * 128 + sch * 8; const bf16_t* Vg = Vp + rowbase * 1024 + h * 128 + sch * 8;
            u32x4 ak0, ak1, av0, av1, bk0, bk1, bv0, bv1;
#define LOADT(S, t) do { const size_t r_ = (size_t)((t) * 64 + sr0) * 1024; S##k0 = *(const u32x4*)(Kg + r_); S##k1 = *(const u32x4*)(Kg + r_ + 32 * 1024); S##v0 = *(const u32x4*)(Vg + r_); S##v1 = *(const u32x4*)(Vg + r_ + 32 * 1024); } while (0)
            LOADT(a, NT - 1); LOADT(b, NT - 2);
            float Bi;
            { float qn = 0.f;
#pragma unroll
              for (int ks = 0; ks < 4; ++ks)
#pragma unroll
                  for (int e2 = 0; e2 < 8; ++e2) { const float v = __builtin_bit_cast(float, ((unsigned)(unsigned short)qf[ks][e2]) << 16); qn += v * v; }
              qn += __shfl_xor(qn, 32);
              Bi = sqrtf(qn) * Kb;
              float dcut = (2.f * Bi + 40.f) / slope2;
#pragma unroll
              for (int o = 1; o < 32; o <<= 1) dcut = fmaxf(dcut, __shfl_xor(dcut, o));
              if (lane == 0) dsh[wave] = dcut; }
            f32x16 O[4];
#pragma unroll
            for (int cb = 0; cb < 4; ++cb)
#pragma unroll
                for (int i = 0; i < 16; ++i) O[cb][i] = 0.f;
            float l = 0.f, Mref = 0.f; bool first = true;
#define STORET(S, bf) do { LAS unsigned char* kb_ = lds + (bf) * BUFB; *(LAS u32x4*)(kb_ + sr0 * KP + sch * 16) = S##k0; *(LAS u32x4*)(kb_ + (sr0 + 32) * KP + sch * 16) = S##k1; \
        *(LAS u32x4*)(kb_ + KBYTES + sr0 * VP + sch * 16) = S##v0; *(LAS u32x4*)(kb_ + KBYTES + (sr0 + 32) * VP + sch * 16) = S##v1; } while (0)
            STORET(a, 0); if (NT >= 3) LOADT(a, NT - 3);
            __syncthreads();
            int NTe = NT; bool fast = false;
            { float dm = dsh[0];
#pragma unroll
              for (int w2 = 1; w2 < 8; ++w2) dm = fmaxf(dm, dsh[w2]);
              const float lim = (float)(q0 - 63) - dm;
              if (lim >= 0.f) { const int tlo = (int)floorf(lim * (1.f / 64)) + 1; NTe = NT - tlo; if (NTe < 2) NTe = 2; }
              fast = (dm * slope2 - 40.f) * 0.5f < 55.f; }
            if (fast) Mref = Bi;
            const int qtop = q0 + 32 * j + 31;
#define ATT_LOOP(FF) do { \
            for (int it = 0; it < NTe; it += 2) { \
                const int t = NT - 1 - it; \
                if (64 * t <= qtop) { attn_tile(FF, lds, 64 * t, qa, hh, r32, c, vrow, vbyte, slope2, qf, O, l, Mref, first); } \
                if (it + 1 < NTe) STORET(b, 1); \
                if (it + 3 < NTe) LOADT(b, t - 3); \
                __syncthreads(); \
                if (it + 1 >= NTe) break; \
                if (64 * (t - 1) <= qtop) { attn_tile(FF, lds + BUFB, 64 * (t - 1), qa, hh, r32, c, vrow, vbyte, slope2, qf, O, l, Mref, first); } \
                if (it + 2 < NTe) STORET(a, 0); \
                if (it + 4 < NTe) LOADT(a, t - 4); \
                __syncthreads(); \
            } \
            } while (0)
            ATT_LOOP(fast);
#undef ATT_LOOP
#undef LOADT
#undef STORET
            const float lt = l + __shfl_xor(l, 32); const float inv = 1.f / lt;
            LAS float* ex = (LAS float*)(lds + EXCH + j * 16384);
            if (c == 1) {
#pragma unroll
                for (int cb = 0; cb < 4; ++cb)
#pragma unroll
                    for (int i = 0; i < 16; ++i) ex[(cb * 16 + i) * 64 + lane] = O[cb][i] * inv;
            }
            __syncthreads();
            if (c == 0) {
                float ss = 0.f;
#pragma unroll
                for (int cb = 0; cb < 4; ++cb)
#pragma unroll
                    for (int i = 0; i < 16; ++i) { const float d = O[cb][i] * inv - lam * ex[(cb * 16 + i) * 64 + lane]; O[cb][i] = d; ss += d * d; }
                ss += __shfl_xor(ss, 32);
                const float rs = 0.8f / sqrtf(ss * (1.f / 128) + EPS);
                const size_t orow = (size_t)(rowbase + qa) * 1024 + h * 128;
#pragma unroll
                for (int cb = 0; cb < 4; ++cb)
#pragma unroll
                    for (int g4 = 0; g4 < 4; ++g4) { const int dv = 32 * cb + 8 * g4 + 4 * hh;
                        const f32x4 gs = *(const f32x4*)(subln_g + dv); const u32x2 z = *(const u32x2*)(SZ + orow + dv);
                        u32x2 w; w.x = cvt_pk_bf16(O[cb][4 * g4] * rs * gs[0] * bflo(z.x), O[cb][4 * g4 + 1] * rs * gs[1] * bfhi(z.x));
                        w.y = cvt_pk_bf16(O[cb][4 * g4 + 2] * rs * gs[2] * bflo(z.y), O[cb][4 * g4 + 3] * rs * gs[3] * bfhi(z.y));
                        *(u32x2*)(AG + orow + dv) = w; }
            }
            if (tid == 0) *nxt_slot = nxt_reg;
        }
        __syncthreads();
        cur = *nxt_slot;
    }
}

__global__ void __launch_bounds__(512, 2) fwd_mega(Args a) {
    extern __shared__ __attribute__((aligned(16))) unsigned char lds_raw[];
    LAS unsigned char* lds = (LAS unsigned char*)lds_raw;
    cg::grid_group grid = cg::this_grid();
    volatile LAS unsigned* MISC = (volatile LAS unsigned*)(lds + LDS_BYTES - 64);
    if (threadIdx.x < 16) MISC[threadIdx.x] = 0u;
    __syncthreads();
    XcdBarrier bar = xcd_barrier_post((unsigned*)(a.ws + WS_BAR), MISC);
    const int G = gridDim.x, bx = blockIdx.x;
    const int vcu = (G % 8 == 0) ? (bx % 8) * (G / 8) + bx / 8 : bx;
    const int lo = a.ph_lo, hi = a.ph_hi;
    unsigned char* ws = a.ws;
    bf16_t* proj = (bf16_t*)(ws + WS_PROJ);
    bf16_t* xb = (bf16_t*)a.out; bf16_t* ag = (bf16_t*)a.out + (size_t)T * 1024;
    bf16_t* ys = (bf16_t*)(ws + WS_YS);
#define IN(k) (lo <= (k) && (k) < hi)
#define SEAM(k) do { if (IN(k) && IN((k) + 1)) { if (lo < 0) grid.sync(); else xcd_barrier(bar); } } while (0)
    if (IN(0)) p0_prologue(a, lds, vcu, G);
    SEAM(0);
    if (IN(1)) {
        __syncthreads();
        pg8::Gemm g{xb, (const bf16_t*)(ws + WS_WIN), T, NIN, 1024}; pg8::StaticOrder S; S.init(T, NIN, G, bx, 3);
        EpiProj E{proj, (unsigned*)(ws + WS_KMAX)};
        pg8::gemm_phase<EpiProj, pg8::StaticOrder, true, true>(lds, g, S, E);
    }
    SEAM(1);
    if (IN(2)) {
        __syncthreads();
        ssm_phase(lds, proj + PU, (const float*)(ws + WS_LBAR), (const float*)(ws + WS_LB256), (const bf16_t*)(ws + WS_BB), (const bf16_t*)(ws + WS_CM), a.in[16], ys, bx, G);
        __syncthreads();
        const int lane = threadIdx.x & 63;
        const float s1 = wave_sum(a.in[3][lane] * a.in[4][lane]), s2 = wave_sum(a.in[5][lane] * a.in[6][lane]);
        const float lam = expf(s1) - expf(s2) + 0.2f;
        attn_phase(lds, proj + PQ, proj + PK, proj + PV, proj + PSZA, ag, a.in[7], lam, (unsigned*)(ws + WS_QCTR), (const unsigned*)(ws + WS_KMAX));
    }
    SEAM(2);
    if (IN(3)) {
        __syncthreads();
        pg8::Gemm g{ys, (const bf16_t*)(ws + WS_WGLU), T, 512, 512}; pg8::StaticOrder S; S.init(T, 512, G, bx);
        EpiGlu E{ys, proj + PSZS, a.in[18], proj + PS};
        pg8::gemm_phase<EpiGlu, pg8::StaticOrder, true, true>(lds, g, S, E);
    }
    SEAM(3);
    if (IN(4)) {
        __syncthreads();
        { pg8::Gemm g{ag, (const bf16_t*)(ws + WS_WOATT), T, 1024, 1024}; pg8::StaticOrder S; S.init(T, 1024, G, bx);
          EpiGate<0> E{proj + PGA, nullptr, proj + PY1};
          pg8::gemm_phase<EpiGate<0>, pg8::StaticOrder, true, true>(lds, g, S, E); }
        __syncthreads();
        { pg8::Gemm g{proj + PS, (const bf16_t*)(ws + WS_WOSSM), T, 1024, 512}; pg8::StaticOrder S; S.init(T, 1024, G, bx);
          EpiGate<1> E{proj + PGS, proj + PY1, proj + PMG};
          pg8::gemm_phase<EpiGate<1>, pg8::StaticOrder, true, true>(lds, g, S, E); }
    }
    SEAM(4);
    if (IN(5)) {
        __syncthreads();
        pg8::Gemm g{proj + PMG, (const bf16_t*)(ws + WS_WOUT), T, 1024, 1024}; pg8::StaticOrder S; S.init(T, 1024, G, bx);
        EpiOutNorm E{a.in[0], a.out, (float*)(ws + WS_ROWSQ), (unsigned*)(ws + WS_CNT), a.in[21]};
        pg8::gemm_phase<EpiOutNorm, pg8::StaticOrder, true, true>(lds, g, S, E);
    }
#undef IN
#undef SEAM
}

extern "C" void kernel_launch(void* const* d_in, const int* in_sizes, int n_in, void* d_out, int out_size, void* d_ws, size_t ws_size, hipStream_t stream) {
    static int grid = 0;
    if (grid == 0) {
        if (n_in != 22 || out_size != T * 1024 || ws_size < WS_END) { fprintf(stderr, "kernel_launch: unexpected shapes (n_in %d out %d ws %zu)\n", n_in, out_size, ws_size); grid = -1; return; }
        int dev = 0, cus = 0, per_cu = 0;
        (void)hipGetDevice(&dev); (void)hipDeviceGetAttribute(&cus, hipDeviceAttributeMultiprocessorCount, dev);
        if (hipFuncSetAttribute((const void*)fwd_mega, hipFuncAttributeMaxDynamicSharedMemorySize, LDS_BYTES) != hipSuccess) { fprintf(stderr, "kernel_launch: hipFuncSetAttribute failed\n"); grid = -1; return; }
        if (hipOccupancyMaxActiveBlocksPerMultiprocessor(&per_cu, (const void*)fwd_mega, 512, LDS_BYTES) != hipSuccess || per_cu < 1) { fprintf(stderr, "kernel_launch: occupancy query failed (%d)\n", per_cu); grid = -1; return; }
        grid = cus * per_cu;
    }
    if (grid < 0) return;
    if (hipMemsetAsync((char*)d_ws + WS_BAR, 0, 32768, stream) != hipSuccess) { fprintf(stderr, "kernel_launch: memset failed\n"); return; }
    Args a{};
    for (int i = 0; i < 22; ++i) a.in[i] = (const float*)d_in[i];
    a.out = (float*)d_out; a.ws = (unsigned char*)d_ws; a.ph_lo = 0; a.ph_hi = 6;
    void* args[] = {&a};
    hipError_t e = hipLaunchCooperativeKernel((const void*)fwd_mega, dim3(grid), dim3(512), args, LDS_BYTES, stream);
    if (e != hipSuccess) fprintf(stderr, "kernel_launch: cooperative launch failed: %s (grid %d)\n", hipGetErrorString(e), grid);
}
```
